# Optimizing an MI355X kernel written in HIP

```python
import math
import numpy as np
import jax
import jax.numpy as jnp
from jax import lax

D_MODEL = 1024
BATCH = 4
SEQ = 8192
DEPTH = 1

CTX_LEN = 256
GRID_W = 64
EPS = 1e-6
CONV_K = 3
CHUNK = 64
N_DIR = 2
N_BRANCH = 2
GDN_HEADS = 8
GDN_DK = 128
GDN_DV = 128
GDN_QK = GDN_HEADS * GDN_DK
GDN_WIDTH = GDN_HEADS * GDN_DV
SSM_INNER = 2 * D_MODEL
SSM_HEAD_DIM = 64
SSM_HEADS = SSM_INNER // SSM_HEAD_DIM
SSM_GROUPS = 4
SSM_STATE = 128
SSM_XBC = SSM_INNER + 2 * SSM_GROUPS * SSM_STATE
D_FF = ((8 * D_MODEL // 3 + 255) // 256) * 256
IN_SIZES = (
    2 * GDN_QK + GDN_WIDTH,
    GDN_WIDTH,
    N_DIR * GDN_HEADS,
    N_DIR * GDN_HEADS,
    SSM_INNER,
    SSM_XBC,
    N_DIR * SSM_HEADS,
    N_BRANCH * D_MODEL,
)
D_IN_PROJ = sum(IN_SIZES)

kernel_name = "bidir_gdn_mamba2_griffin_merge_prefix_ctx"


def _split_cols(t, sizes):
    idx = np.cumsum(np.array(sizes))[:-1].tolist()
    return jnp.split(t, idx, axis=-1)


def _rmsnorm(x, w):
    x32 = x.astype(jnp.float32)
    y = x32 * lax.rsqrt(jnp.mean(x32 * x32, axis=-1, keepdims=True) + EPS)
    return y.astype(x.dtype) * w


def _l2norm(x):
    x32 = x.astype(jnp.float32)
    return (x32 * lax.rsqrt(jnp.sum(x32 * x32, axis=-1, keepdims=True) + EPS)).astype(x.dtype)


def _flip(t):
    return jnp.flip(t, axis=1)


def _dwconv_centred(u, w, b):
    pad = CONV_K // 2
    length = u.shape[-2]
    up = jnp.pad(u, [(0, 0)] * (u.ndim - 2) + [(pad, pad), (0, 0)])
    out = b
    for j in range(CONV_K):
        out = out + up[..., j:j + length, :] * w[j]
    return out


def _short_conv(u, w, b, latent):
    if latent:
        bsz, length, ch = u.shape
        rows = length // GRID_W
        return _dwconv_centred(u.reshape(bsz, rows, GRID_W, ch), w, b).reshape(bsz, length, ch)
    return _dwconv_centred(u, w, b)


def _to_chunks(t):
    bsz, length = t.shape[:2]
    return jnp.moveaxis(t.reshape(bsz, length // CHUNK, CHUNK, *t.shape[2:]), 1, 0)


def _from_chunks(t):
    t = jnp.moveaxis(t, 0, 1)
    return t.reshape(t.shape[0], t.shape[1] * t.shape[2], *t.shape[3:])


def _gdn_chunked(q, k, v, g, beta, s0):
    out_dtype = v.dtype
    q, k, v, g, beta = (t.astype(jnp.float32) for t in (q, k, v, g, beta))
    idx = jnp.arange(CHUNK)
    incl = idx[:, None] >= idx[None, :]
    strict = idx[:, None] > idx[None, :]
    eye = jnp.eye(CHUNK, dtype=jnp.float32)

    def step(s, inp):
        qc, kc, vc, gc, bc = inp
        qh, kh, vh = (jnp.swapaxes(t, 1, 2) for t in (qc, kc, vc))
        gcum = jnp.cumsum(jnp.swapaxes(gc, 1, 2), axis=-1)
        bh = jnp.swapaxes(bc, 1, 2)[..., None]
        decay = jnp.exp(jnp.where(incl, gcum[..., :, None] - gcum[..., None, :], -jnp.inf))
        kb = kh * bh
        lower = jnp.where(strict, jnp.einsum('bhid,bhjd->bhij', kb, kh) * decay, 0.0) + eye
        rhs = jnp.concatenate([kb * jnp.exp(gcum)[..., None], vh * bh], axis=-1)
        sol = lax.linalg.triangular_solve(lower, rhs, left_side=True, lower=True, unit_diagonal=True)
        w_c, u_c = sol[..., :GDN_DK], sol[..., GDN_DK:]
        v_new = u_c - jnp.einsum('bhck,bhkv->bhcv', w_c, s)
        attn = jnp.einsum('bhik,bhjk->bhij', qh, kh) * decay
        o = (jnp.einsum('bhck,bhkv->bhcv', qh * jnp.exp(gcum)[..., None], s)
             + jnp.einsum('bhij,bhjv->bhiv', attn, v_new))
        g_last = gcum[..., -1:]
        s = (s * jnp.exp(g_last)[..., None]
             + jnp.einsum('bhck,bhcv->bhkv', kh * jnp.exp(g_last - gcum)[..., None], v_new))
        return s, jnp.swapaxes(o, 1, 2)

    s_fin, o = lax.scan(step, s0, tuple(_to_chunks(t) for t in (q, k, v, g, beta)))
    return _from_chunks(o).astype(out_dtype), s_fin


def _ssd_chunked(x, dt, a, bm, cm, h0):
    out_dtype = x.dtype
    x, dt, bm, cm = (t.astype(jnp.float32) for t in (x, dt, bm, cm))
    bsz = x.shape[0]
    rep = SSM_HEADS // SSM_GROUPS
    idx = jnp.arange(CHUNK)
    incl = idx[:, None] >= idx[None, :]

    def step(h, inp):
        xc, dtc, bc, cc = inp
        acum = jnp.cumsum(jnp.swapaxes(dtc * a, 1, 2), axis=-1).reshape(bsz, SSM_GROUPS, rep, CHUNK)
        seg = jnp.exp(jnp.where(incl, acum[..., :, None] - acum[..., None, :], -jnp.inf))
        xdt = (xc * dtc[..., None]).reshape(bsz, CHUNK, SSM_GROUPS, rep, SSM_HEAD_DIM)
        cb = jnp.einsum('bign,bjgn->bgij', cc, bc)
        y_diag = jnp.einsum('bgij,bgrij,bjgrp->bigrp', cb, seg, xdt)
        hg = h.reshape(bsz, SSM_GROUPS, rep, SSM_HEAD_DIM, SSM_STATE)
        y_off = jnp.einsum('bign,bgrpn,bgri->bigrp', cc, hg, jnp.exp(acum))
        a_last = acum[..., -1:]
        new = jnp.einsum('bjgn,bgrj,bjgrp->bgrpn', bc, jnp.exp(a_last - acum), xdt)
        hg = hg * jnp.exp(a_last)[..., None] + new
        y = (y_diag + y_off).reshape(bsz, CHUNK, SSM_HEADS, SSM_HEAD_DIM)
        return hg.reshape(h.shape), y

    h_fin, y = lax.scan(step, h0, tuple(_to_chunks(t) for t in (x, dt, bm, cm)))
    return _from_chunks(y).astype(out_dtype), h_fin


def _gdn_bidir(q, k, v, g, beta, s_f, s_b):
    o_f, s_f = _gdn_chunked(q, k, v, g[:, :, 0], beta[:, :, 0], s_f)
    o_b, s_b = _gdn_chunked(_flip(q), _flip(k), _flip(v), _flip(g[:, :, 1]), _flip(beta[:, :, 1]), s_b)
    return o_f + _flip(o_b), s_f, s_b


def _ssd_bidir(xs, dt, a_log, bm, cm, h_f, h_b):
    a = -jnp.exp(a_log.astype(jnp.float32))
    y_f, h_f = _ssd_chunked(xs, dt[:, :, 0], a[0], bm, cm, h_f)
    y_b, h_b = _ssd_chunked(_flip(xs), _flip(dt[:, :, 1]), a[1], _flip(bm), _flip(cm), h_b)
    return y_f + _flip(y_b), h_f, h_b


def _mixer_inputs(h, latent, w_in, gdn_conv_w, gdn_conv_b, gdn_a_log, gdn_dt_bias,
                  ssm_conv_w, ssm_conv_b, ssm_dt_bias):
    bsz, length, _ = h.shape
    qkv, z_gdn, a_gdn, b_gdn, z_ssm, xbc, dt_raw, br_gate = _split_cols(h @ w_in, IN_SIZES)
    qkv = jax.nn.silu(_short_conv(qkv, gdn_conv_w, gdn_conv_b, latent))
    q, k, v = _split_cols(qkv, (GDN_QK, GDN_QK, GDN_WIDTH))
    q = _l2norm(q.reshape(bsz, length, GDN_HEADS, GDN_DK)) * GDN_DK ** -0.5
    k = _l2norm(k.reshape(bsz, length, GDN_HEADS, GDN_DK))
    v = v.reshape(bsz, length, GDN_HEADS, GDN_DV)
    g = -jnp.exp(gdn_a_log) * jax.nn.softplus(a_gdn.reshape(bsz, length, N_DIR, GDN_HEADS) + gdn_dt_bias)
    beta = jax.nn.sigmoid(b_gdn.reshape(bsz, length, N_DIR, GDN_HEADS))
    xbc = jax.nn.silu(_short_conv(xbc, ssm_conv_w, ssm_conv_b, latent))
    xs, bm, cm = _split_cols(xbc, (SSM_INNER, SSM_GROUPS * SSM_STATE, SSM_GROUPS * SSM_STATE))
    xs = xs.reshape(bsz, length, SSM_HEADS, SSM_HEAD_DIM)
    bm = bm.reshape(bsz, length, SSM_GROUPS, SSM_STATE)
    cm = cm.reshape(bsz, length, SSM_GROUPS, SSM_STATE)
    dt = jax.nn.softplus(dt_raw.reshape(bsz, length, N_DIR, SSM_HEADS) + ssm_dt_bias)
    return q, k, v, g, beta, z_gdn, xs, bm, cm, dt, z_ssm, br_gate


def _mixer_output(o_gdn, z_gdn, y_ssm, xs, z_ssm, br_gate, gdn_norm_w, ssm_d, ssm_norm_w,
                  w_br_gdn, w_br_ssm, w_out):
    bsz, length = o_gdn.shape[:2]
    o = _rmsnorm(o_gdn, gdn_norm_w) * jax.nn.silu(z_gdn.reshape(bsz, length, GDN_HEADS, GDN_DV))
    p_gdn = o.reshape(bsz, length, GDN_WIDTH) @ w_br_gdn
    y = (y_ssm + ssm_d[:, None] * xs).reshape(bsz, length, SSM_INNER) * jax.nn.silu(z_ssm)
    y = _rmsnorm(y.reshape(bsz, length, SSM_GROUPS, SSM_INNER // SSM_GROUPS),
                 ssm_norm_w.reshape(SSM_GROUPS, SSM_INNER // SSM_GROUPS)).reshape(bsz, length, SSM_INNER)
    p_ssm = y @ w_br_ssm
    gate_gdn, gate_ssm = jnp.split(br_gate, N_BRANCH, axis=-1)
    merged = jax.nn.sigmoid(gate_gdn) * p_gdn + jax.nn.sigmoid(gate_ssm) * p_ssm
    return merged @ w_out


def _swiglu(h, w_ffn_in, w_ffn_out):
    gate, up = jnp.split(h @ w_ffn_in, 2, axis=-1)
    return (jax.nn.silu(gate) * up) @ w_ffn_out


def setup_inputs(seed: int = 0) -> dict:
    key = jax.random.key(seed)
    ks = jax.random.split(key, 26)

    def nrm(i, shape, scale):
        return scale * jax.random.normal(ks[i], shape, jnp.float32)

    def gain(i, shape):
        return 1.0 + 0.02 * jax.random.normal(ks[i], shape, jnp.float32)

    def a_log(i, shape):
        return jnp.log(jax.random.uniform(ks[i], shape, jnp.float32, 1.0, 16.0))

    def dt_bias(i, shape):
        dt = jnp.exp(jax.random.uniform(ks[i], shape, jnp.float32, math.log(1e-3), math.log(1e-1)))
        return dt + jnp.log(-jnp.expm1(-dt))

    return {
        "x": nrm(0, (BATCH, SEQ, D_MODEL), 1.0),
        "c": nrm(1, (BATCH, D_MODEL), 1.0),
        "ctx": nrm(2, (BATCH, CTX_LEN, D_MODEL), 1.0),
        "c_ctx": nrm(3, (D_MODEL,), 1.0),
        "ada_w": nrm(4, (DEPTH, D_MODEL, 6 * D_MODEL), 0.5 * D_MODEL ** -0.5),
        "ada_b": nrm(5, (DEPTH, 6 * D_MODEL), 0.01),
        "norm1_w": gain(6, (DEPTH, D_MODEL)),
        "w_in": nrm(7, (DEPTH, D_MODEL, D_IN_PROJ), D_MODEL ** -0.5),
        "gdn_conv_w": nrm(8, (DEPTH, CONV_K, 2 * GDN_QK + GDN_WIDTH), CONV_K ** -0.5),
        "gdn_conv_b": nrm(9, (DEPTH, 2 * GDN_QK + GDN_WIDTH), 0.01),
        "gdn_a_log": a_log(10, (DEPTH, N_DIR, GDN_HEADS)),
        "gdn_dt_bias": dt_bias(11, (DEPTH, N_DIR, GDN_HEADS)),
        "gdn_norm_w": gain(12, (DEPTH, GDN_DV)),
        "ssm_conv_w": nrm(13, (DEPTH, CONV_K, SSM_XBC), CONV_K ** -0.5),
        "ssm_conv_b": nrm(14, (DEPTH, SSM_XBC), 0.01),
        "ssm_a_log": a_log(15, (DEPTH, N_DIR, SSM_HEADS)),
        "ssm_dt_bias": dt_bias(16, (DEPTH, N_DIR, SSM_HEADS)),
        "ssm_d": gain(17, (DEPTH, SSM_HEADS)),
        "ssm_norm_w": gain(18, (DEPTH, SSM_INNER)),
        "w_br_gdn": nrm(19, (DEPTH, GDN_WIDTH, D_MODEL), GDN_WIDTH ** -0.5),
        "w_br_ssm": nrm(20, (DEPTH, SSM_INNER, D_MODEL), SSM_INNER ** -0.5),
        "w_out": nrm(21, (DEPTH, D_MODEL, D_MODEL), D_MODEL ** -0.5),
        "norm2_w": gain(22, (DEPTH, D_MODEL)),
        "w_ffn_in": nrm(23, (DEPTH, D_MODEL, 2 * D_FF), D_MODEL ** -0.5),
        "w_ffn_out": nrm(24, (DEPTH, D_FF, D_MODEL), D_FF ** -0.5),
        "norm_f_w": gain(25, (D_MODEL,)),
    }


def reference(x, c, ctx, c_ctx, ada_w, ada_b, norm1_w, w_in, gdn_conv_w, gdn_conv_b, gdn_a_log,
              gdn_dt_bias, gdn_norm_w, ssm_conv_w, ssm_conv_b, ssm_a_log, ssm_dt_bias, ssm_d,
              ssm_norm_w, w_br_gdn, w_br_ssm, w_out, norm2_w, w_ffn_in, w_ffn_out, norm_f_w):
    bsz = x.shape[0]
    silu_c = jax.nn.silu(c)[:, None, :]
    silu_cc = jax.nn.silu(c_ctx)
    h_lat, h_ctx = x, ctx
    for i in range(DEPTH):
        sh1, sc1, g1, sh2, sc2, g2 = jnp.split(silu_c @ ada_w[i] + ada_b[i], 6, axis=-1)
        csh1, csc1, cg1, csh2, csc2, cg2 = jnp.split(silu_cc @ ada_w[i] + ada_b[i], 6, axis=-1)
        prm = (w_in[i], gdn_conv_w[i], gdn_conv_b[i], gdn_a_log[i], gdn_dt_bias[i],
               ssm_conv_w[i], ssm_conv_b[i], ssm_dt_bias[i])
        a_lat = _rmsnorm(h_lat, norm1_w[i]) * (1 + sc1) + sh1
        a_ctx = _rmsnorm(h_ctx, norm1_w[i]) * (1 + csc1) + csh1
        (cq, ck, cv, cgd, cbeta, cz_gdn, cxs, cbm, ccm, cdt, cz_ssm, cgate) = _mixer_inputs(a_ctx, False, *prm)
        (lq, lk, lv, lgd, lbeta, lz_gdn, lxs, lbm, lcm, ldt, lz_ssm, lgate) = _mixer_inputs(a_lat, True, *prm)
        s0 = jnp.zeros((bsz, GDN_HEADS, GDN_DK, GDN_DV), jnp.float32)
        h0 = jnp.zeros((bsz, SSM_HEADS, SSM_HEAD_DIM, SSM_STATE), jnp.float32)
        co_gdn, s_f, s_b = _gdn_bidir(cq, ck, cv, cgd, cbeta, s0, s0)
        lo_gdn, _, _ = _gdn_bidir(lq, lk, lv, lgd, lbeta, s_f, s_b)
        cy_ssm, hf, hb = _ssd_bidir(cxs, cdt, ssm_a_log[i], cbm, ccm, h0, h0)
        ly_ssm, _, _ = _ssd_bidir(lxs, ldt, ssm_a_log[i], lbm, lcm, hf, hb)
        out_prm = (gdn_norm_w[i], ssm_d[i], ssm_norm_w[i], w_br_gdn[i], w_br_ssm[i], w_out[i])
        h_lat = h_lat + g1 * _mixer_output(lo_gdn, lz_gdn, ly_ssm, lxs, lz_ssm, lgate, *out_prm)
        f_lat = _rmsnorm(h_lat, norm2_w[i]) * (1 + sc2) + sh2
        h_lat = h_lat + g2 * _swiglu(f_lat, w_ffn_in[i], w_ffn_out[i])
        if i < DEPTH - 1:
            h_ctx = h_ctx + cg1 * _mixer_output(co_gdn, cz_gdn, cy_ssm, cxs, cz_ssm, cgate, *out_prm)
            f_ctx = _rmsnorm(h_ctx, norm2_w[i]) * (1 + csc2) + csh2
            h_ctx = h_ctx + cg2 * _swiglu(f_ctx, w_ffn_in[i], w_ffn_out[i])
    return _rmsnorm(h_lat, norm_f_w)
```

```cpp
#include <hip/hip_runtime.h>
#include <hip/hip_cooperative_groups.h>
#include <cstdio>
#include <cstdint>
namespace cg = cooperative_groups;


#ifndef MK_PER_PHASE
#define MK_PER_PHASE 0
#endif

#define LAS __attribute__((address_space(3)))
typedef unsigned short bf16_t;
typedef short bf16x8 __attribute__((ext_vector_type(8)));
typedef short bf16x4 __attribute__((ext_vector_type(4)));
typedef float f32x4 __attribute__((ext_vector_type(4)));
typedef float f32x2 __attribute__((ext_vector_type(2)));
typedef unsigned u32x4 __attribute__((ext_vector_type(4)));
typedef unsigned u32x2 __attribute__((ext_vector_type(2)));

constexpr int NB = 4, SEQ = 8192, DM = 1024, CTXL = 256;
constexpr int M_LAT = NB * SEQ, M_CTX = NB * CTXL, M_ALL = M_LAT + M_CTX;
constexpr int NCH_LAT = M_LAT / 64, NCH = M_ALL / 64;
constexpr int D_IN = 11360, N1A = 3328, N1B = 3072, NZ = 5120, DFF = 2816, NF1 = 2 * DFF;
constexpr int QKV_LD = 3072, XBC_LD = 3072, SMALL_LD = 96;
constexpr float EPS = 1e-6f;

constexpr size_t MiB = 1u << 20;
constexpr size_t WS_CTL = 0;
constexpr size_t WS_MOD = 1 * MiB;
constexpr size_t WS_PAR = 1 * MiB + 512 * 1024;
constexpr size_t WS_OST = 2 * MiB;
constexpr size_t WS_RAT = 12 * MiB;
constexpr size_t WS_OST_UNUSED = 0;
constexpr size_t WS_PS = 3 * MiB;
constexpr size_t WS_GC = 3 * MiB;
constexpr size_t WS_W1A = 14 * MiB;
constexpr size_t WS_W1B = WS_W1A + (size_t)N1A * 1024 * 2;
constexpr size_t WS_WZ = WS_W1B + (size_t)N1B * 1024 * 2;
constexpr size_t WS_WBG = WS_WZ + (size_t)NZ * 1024 * 2;
constexpr size_t WS_WBS = WS_WBG + (size_t)1024 * 1024 * 2;
constexpr size_t WS_WO = WS_WBS + (size_t)1024 * 2048 * 2;
constexpr size_t WS_WF1 = WS_WO + (size_t)1024 * 1024 * 2;
constexpr size_t WS_WF2 = WS_WF1 + (size_t)NF1 * 1024 * 2;
constexpr size_t WS_WEND = WS_WF2 + (size_t)1024 * DFF * 2;
static_assert(WS_WEND <= 61 * MiB, "weights");
constexpr size_t WS_SMALL = 61 * MiB;
constexpr size_t WS_A = 74 * MiB;
constexpr size_t WS_BIG = 140 * MiB;
constexpr size_t WS_QKV = WS_BIG;
constexpr size_t WS_XBC = WS_BIG;
constexpr size_t WS_TA = 338 * MiB;
constexpr size_t WS_Y = 384 * MiB;
constexpr size_t WS_GATES = 140 * MiB;
constexpr size_t WS_M1 = 268 * MiB;
constexpr size_t WS_P = 140 * MiB;
constexpr size_t WS_H1 = 204 * MiB;
constexpr size_t WS_F = 268 * MiB;
constexpr size_t WS_ACT = 336 * MiB;
constexpr size_t WS_END = 512 * MiB;

constexpr int LDS_BYTES = 160 * 1024;
constexpr int RING_BYTES = 131072;
constexpr int XL_OFF = RING_BYTES;

typedef __bf16 bf16x2_t __attribute__((ext_vector_type(2)));
__device__ __forceinline__ unsigned cvt_pk_bf16(float lo, float hi) { const f32x2 v = {lo, hi}; const bf16x2_t b = __builtin_convertvector(v, bf16x2_t); return __builtin_bit_cast(unsigned, b); }
__device__ __forceinline__ float bf2f(unsigned short h) { return __uint_as_float((unsigned)h << 16); }
__device__ __forceinline__ float bflo(unsigned w) { return __uint_as_float(w << 16); }
__device__ __forceinline__ float bfhi(unsigned w) { return __uint_as_float(w & 0xffff0000u); }
__device__ __forceinline__ bf16_t f2bf(float f) { return (bf16_t)(cvt_pk_bf16(f, 0.f) & 0xffffu); }
__device__ __forceinline__ float sigmoidf_(float x) { return __builtin_amdgcn_rcpf(1.f + __expf(-x)); }
__device__ __forceinline__ float siluf_(float x) { return x * __builtin_amdgcn_rcpf(1.f + __expf(-x)); }
__device__ __forceinline__ float softplusf_(float x) { return fmaxf(x, 0.f) + log1pf(expf(-fabsf(x))); }
__device__ __forceinline__ float wave_sum(float v) {
#pragma unroll
    for (int o = 1; o < 64; o <<= 1) v += __shfl_xor(v, o);
    return v;
}
__device__ __forceinline__ void unpack8(u32x4 w, float (&f)[8]) { f[0] = bflo(w.x); f[1] = bfhi(w.x); f[2] = bflo(w.y); f[3] = bfhi(w.y); f[4] = bflo(w.z); f[5] = bfhi(w.z); f[6] = bflo(w.w); f[7] = bfhi(w.w); }
__device__ __forceinline__ u32x4 pack8(const float (&f)[8]) { u32x4 w; w.x = cvt_pk_bf16(f[0], f[1]); w.y = cvt_pk_bf16(f[2], f[3]); w.z = cvt_pk_bf16(f[4], f[5]); w.w = cvt_pk_bf16(f[6], f[7]); return w; }

namespace pg8 {
#define PG8_LAS __attribute__((address_space(3)))
constexpr int BM = 256, BK = 64, HALF = 128, HTB = HALF * BK * 2  , STAGE_BYTES = 8 * HTB, NXCD = 8, WGM = 8;
__host__ __device__ __forceinline__ int lds_byte(int r, int c) { const int st = (r >> 4) * 2 + (c >> 5), rr = r & 15, cc = c & 31, ob = rr * 64 + cc * 2; return st * 1024 + (ob ^ (((ob >> 9) & 1) << 5)); }
__host__ __device__ __forceinline__ void stage_rc(int b, int& R, int& C) { const int st = b / 1024, sb = b % 1024, swz = sb ^ (((sb >> 9) & 1) << 5); R = (st >> 1) * 16 + swz / 64; C = (st & 1) * 32 + (swz % 64) / 2; }
__host__ __device__ __forceinline__ int perm32(int rho) { const int n = rho >> 4, i = rho & 15; return 8 * (i >> 2) + 4 * n + (i & 3); }
struct Unit { int pm, pn; };
struct Gemm { const bf16_t* A; const bf16_t* Bt; int M, N, K; };
struct StaticOrder {
    int nM, nN, nwg, G, c;
    __host__ __device__ void init(int M, int N, int G_, int c_) { nM = M / BM; nN = N / BM; nwg = nM * nN; G = G_; c = c_; }
    __host__ __device__ bool next(int i, Unit& u) const {
        const long L = (long)i * G + c; if (L >= nwg) return false;
        int wgid = (int)L; { const int q = nwg / NXCD, r = nwg % NXCD, xcd = wgid % NXCD, off = wgid / NXCD; wgid = (xcd < r ? xcd * (q + 1) : r * (q + 1) + (xcd - r) * q) + off; }
        const int nig = WGM * nN, gid = wgid / nig, fm = gid * WGM, gsz = (nM - fm) < WGM ? (nM - fm) : WGM;
        u.pm = fm + ((wgid % nig) % gsz); u.pn = (wgid % nig) / gsz; return true;
    }
    __device__ __forceinline__ void a_ready(const Unit&) const {}
    __device__ __forceinline__ void done(const Unit&) const {}
};
template <class Epi, class Sched, bool ALIGN_EPI = false, bool SP2 = false>
__device__ __forceinline__ void gemm_phase(PG8_LAS unsigned char* lds, const Gemm g, const Sched& S, const Epi& E) {
    const int tid = threadIdx.x, wid = __builtin_amdgcn_readfirstlane(tid >> 6), lane = tid & 63, wr = wid >> 2, wc = wid & 3, fr = lane & 15, fq = lane >> 4;
    const int K = g.K, nt = K / BK;
    unsigned voffA[2], voffB[2];
#pragma unroll
    for (int i = 0; i < 2; ++i) { int R, C; stage_rc(tid * 16 + i * 8192, R, C); const int Rb = Epi::PERM ? ((R & ~31) + perm32(R & 31)) : R;
        voffA[i] = (unsigned)(R * K + C) * 2u; voffB[i] = (unsigned)(Rb * K + C) * 2u; }
    const size_t kstep = (size_t)(BK * 2);
    const size_t hstep = (size_t)HALF * K * 2;
    const size_t tstep = 2 * hstep;
    const unsigned ldsw = (unsigned)wid * 1024u;
    const int aoff = lds_byte(wr * 64 + fr, fq * 8), boff = lds_byte(wc * 32 + fr, fq * 8);
#define PG8_SA(b, h) (((b) * 2 + (h)) * HTB)
#define PG8_SB(b, h) ((4 + (b) * 2 + (h)) * HTB)
#define PG8_STAGE(bufoff, gbase, voff) do { _Pragma("unroll") for (int _i = 0; _i < 2; ++_i) \
        __builtin_amdgcn_global_load_lds((const unsigned*)((const char*)(gbase) + (voff)[_i]), (PG8_LAS unsigned*)(lds + (bufoff) + ldsw + _i * 8192), 16, 0, 0); } while (0)
#define PG8_LDA(dst, b, h) do { _Pragma("unroll") for (int m = 0; m < 4; ++m) _Pragma("unroll") for (int k = 0; k < 2; ++k) dst[m][k] = *(const PG8_LAS bf16x8*)(lds + PG8_SA(b, h) + aoff + m * 2048 + k * 1024); } while (0)
#define PG8_LDB(dst, b, h) do { _Pragma("unroll") for (int n = 0; n < 2; ++n) _Pragma("unroll") for (int k = 0; k < 2; ++k) dst[n][k] = *(const PG8_LAS bf16x8*)(lds + PG8_SB(b, h) + boff + n * 2048 + k * 1024); } while (0)
#define PG8_MMA(ai, bj, At, Bt) do { __builtin_amdgcn_s_setprio(1); _Pragma("unroll") for (int m = 0; m < 4; ++m) _Pragma("unroll") for (int n = 0; n < 2; ++n) _Pragma("unroll") for (int k = 0; k < 2; ++k) \
        acc[ai][bj][m][n] = __builtin_amdgcn_mfma_f32_16x16x32_bf16(Bt[n][k], At[m][k], acc[ai][bj][m][n], 0, 0, 0); __builtin_amdgcn_s_setprio(0); } while (0)
#define PG8_WAIT_V(n) asm volatile("s_waitcnt vmcnt(" #n ")" ::: "memory")
#define PG8_WAIT_L(n) asm volatile("s_waitcnt lgkmcnt(" #n ")" ::: "memory")
#define PG8_BAR __builtin_amdgcn_s_barrier()
#define PG8_SCHED __builtin_amdgcn_sched_barrier(0)
    Unit cur, nxt; int ui = 0;
    if (!S.next(0, cur)) return;
#ifdef PG8_STAGGER
    { const int g_ = (blockIdx.x >> 3) & 3; for (int i_ = 0; i_ < g_ * PG8_STAGGER; ++i_) __builtin_amdgcn_s_sleep(127); }
#endif
    f32x4 acc[2][2][4][2];
#pragma unroll
    for (int a = 0; a < 2; ++a)
#pragma unroll
        for (int b = 0; b < 2; ++b)
#pragma unroll
            for (int m = 0; m < 4; ++m)
#pragma unroll
                for (int n = 0; n < 2; ++n) acc[a][b][m][n] = (f32x4){0.f, 0.f, 0.f, 0.f};
    bf16x8 At[4][2], B0[2][2], B1[2][2];
    const char* cA = (const char*)g.A + (size_t)cur.pm * tstep; const char* cB = (const char*)g.Bt + (size_t)cur.pn * tstep;
    S.a_ready(cur);
    if constexpr (SP2) {
        PG8_STAGE(PG8_SB(0, 0), cB, voffB); PG8_STAGE(PG8_SB(0, 1), cB + hstep, voffB); PG8_STAGE(PG8_SA(0, 0), cA, voffA); PG8_STAGE(PG8_SA(0, 1), cA + hstep, voffA);
        if (wr == 1) PG8_BAR;
        PG8_WAIT_V(2); PG8_BAR;
        PG8_STAGE(PG8_SB(1, 0), cB + kstep, voffB); PG8_STAGE(PG8_SA(1, 0), cA + kstep, voffA); PG8_STAGE(PG8_SB(1, 1), cB + hstep + kstep, voffB);
        PG8_WAIT_V(6); PG8_BAR;
    } else {
        PG8_STAGE(PG8_SB(0, 0), cB, voffB); PG8_STAGE(PG8_SA(0, 0), cA, voffA); PG8_STAGE(PG8_SB(0, 1), cB + hstep, voffB); PG8_STAGE(PG8_SA(0, 1), cA + hstep, voffA);
        if (wr == 1) PG8_BAR;
        PG8_WAIT_V(4); PG8_BAR;
        PG8_STAGE(PG8_SB(1, 0), cB + kstep, voffB); PG8_STAGE(PG8_SA(1, 0), cA + kstep, voffA); PG8_STAGE(PG8_SB(1, 1), cB + hstep + kstep, voffB);
        PG8_WAIT_V(6); PG8_BAR;
    }
    for (;;) {
        const bool has_next = S.next(ui + 1, nxt);
        const char* nA = has_next ? (const char*)g.A + (size_t)nxt.pm * tstep : cA; const char* nB = has_next ? (const char*)g.Bt + (size_t)nxt.pn * tstep : cB;
        for (int t = 0; t < nt; t += 2) {
            const bool last = (t == nt - 2);
            const char* a1 = cA + (size_t)(t + 1) * kstep;
            const char* a2 = last ? nA : cA + (size_t)(t + 2) * kstep; const char* b2 = last ? nB : cB + (size_t)(t + 2) * kstep;
            const char* a3 = a2 + kstep; const char* b3 = b2 + kstep;
            if (last && has_next) S.a_ready(nxt);
            if constexpr (Epi::KSCALE) { if (t == 8 || t == 16 || t == 24) E.kscale(acc, cur, t >> 3, wr, fr); }
            if constexpr (SP2) {
            PG8_LDB(B0, 0, 0); PG8_LDB(B1, 0, 1); PG8_SCHED; PG8_LDA(At, 0, 0); PG8_STAGE(PG8_SA(1, 1), a1 + hstep, voffA);
            PG8_WAIT_V(8); PG8_WAIT_L(0); PG8_BAR; PG8_MMA(0, 0, At, B0); PG8_MMA(0, 1, At, B1); PG8_BAR; PG8_SCHED;
            PG8_LDA(At, 0, 1); PG8_STAGE(PG8_SB(0, 0), b2, voffB); PG8_STAGE(PG8_SB(0, 1), b2 + hstep, voffB); PG8_STAGE(PG8_SA(0, 0), a2, voffA);
            PG8_WAIT_V(8); PG8_WAIT_L(0); PG8_BAR; PG8_MMA(1, 0, At, B0); PG8_MMA(1, 1, At, B1); PG8_BAR; PG8_SCHED;
            PG8_LDB(B0, 1, 0); PG8_LDB(B1, 1, 1); PG8_SCHED; PG8_LDA(At, 1, 0); PG8_STAGE(PG8_SA(0, 1), a2 + hstep, voffA);
            PG8_WAIT_V(8); PG8_WAIT_L(0); PG8_BAR; PG8_MMA(0, 0, At, B0); PG8_MMA(0, 1, At, B1); PG8_BAR; PG8_SCHED;
            PG8_LDA(At, 1, 1); PG8_STAGE(PG8_SB(1, 0), b3, voffB); PG8_STAGE(PG8_SB(1, 1), b3 + hstep, voffB); PG8_STAGE(PG8_SA(1, 0), a3, voffA);
            PG8_WAIT_V(8); PG8_WAIT_L(0); PG8_BAR; PG8_MMA(1, 0, At, B0); PG8_MMA(1, 1, At, B1); PG8_BAR; PG8_SCHED;
            } else {
            PG8_LDB(B0, 0, 0); PG8_SCHED; PG8_LDA(At, 0, 0); PG8_STAGE(PG8_SA(1, 1), a1 + hstep, voffA);
            PG8_WAIT_L(8); PG8_BAR; PG8_WAIT_L(0); PG8_MMA(0, 0, At, B0); PG8_BAR; PG8_SCHED;
            PG8_LDB(B1, 0, 1); PG8_STAGE(PG8_SB(0, 0), b2, voffB);
            PG8_BAR; PG8_WAIT_L(0); PG8_MMA(0, 1, At, B1); PG8_BAR;
            PG8_LDA(At, 0, 1); PG8_STAGE(PG8_SA(0, 0), a2, voffA);
            PG8_BAR; PG8_WAIT_L(0); PG8_MMA(1, 0, At, B0); PG8_BAR; PG8_SCHED;
            PG8_STAGE(PG8_SB(0, 1), b2 + hstep, voffB);
            PG8_WAIT_V(6); PG8_BAR; PG8_MMA(1, 1, At, B1); PG8_BAR;
            PG8_LDB(B0, 1, 0); PG8_SCHED; PG8_LDA(At, 1, 0); PG8_STAGE(PG8_SA(0, 1), a2 + hstep, voffA);
            PG8_WAIT_L(8); PG8_BAR; PG8_WAIT_L(0); PG8_MMA(0, 0, At, B0); PG8_BAR; PG8_SCHED;
            PG8_LDB(B1, 1, 1); PG8_STAGE(PG8_SB(1, 0), b3, voffB);
            PG8_BAR; PG8_WAIT_L(0); PG8_MMA(0, 1, At, B1); PG8_BAR;
            PG8_LDA(At, 1, 1); PG8_STAGE(PG8_SA(1, 0), a3, voffA);
            PG8_BAR; PG8_WAIT_L(0); PG8_MMA(1, 0, At, B0); PG8_BAR; PG8_SCHED;
            PG8_STAGE(PG8_SB(1, 1), b3 + hstep, voffB);
            PG8_WAIT_V(6); PG8_BAR; PG8_MMA(1, 1, At, B1); PG8_BAR;
            }
        }
        if constexpr (ALIGN_EPI) { if (wr == 0) PG8_BAR; }
        if constexpr (!Epi::AFTER_DRAIN) { E(acc, cur, wr, wc, fr, fq); S.done(cur); }
        if (!has_next) break;
#pragma unroll
        for (int a = 0; a < 2; ++a)
#pragma unroll
            for (int b = 0; b < 2; ++b)
#pragma unroll
                for (int m = 0; m < 4; ++m)
#pragma unroll
                    for (int n = 0; n < 2; ++n) acc[a][b][m][n] = (f32x4){0.f, 0.f, 0.f, 0.f};
        cur = nxt; cA = nA; cB = nB; ++ui;
        if constexpr (ALIGN_EPI) { if (wr == 1) PG8_BAR; }
    }
    PG8_WAIT_V(0);
    if constexpr (!ALIGN_EPI) { if (wr == 0) PG8_BAR; }
    PG8_BAR;
    if constexpr (Epi::AFTER_DRAIN) { E.fused(acc, cur, wr, wc, fr, fq, lds, wid, lane); S.done(cur); }
#undef PG8_SA
#undef PG8_SB
#undef PG8_STAGE
#undef PG8_LDA
#undef PG8_LDB
#undef PG8_MMA
#undef PG8_WAIT_V
#undef PG8_WAIT_L
#undef PG8_BAR
#undef PG8_SCHED
}
}

using pg8::Unit; using pg8::HALF; using pg8::BM;
#define ACC_T const f32x4 (&acc)[2][2][4][2]
#define EPI_FOR_AI_M _Pragma("unroll") for (int ai = 0; ai < 2; ++ai) _Pragma("unroll") for (int m = 0; m < 4; ++m)
__device__ __forceinline__ void acc8(ACC_T, int ai, int bj, int m, float (&v)[8]) {
    const f32x4 a = acc[ai][bj][m][0], b = acc[ai][bj][m][1];
    v[0] = a[0]; v[1] = a[1]; v[2] = a[2]; v[3] = a[3]; v[4] = b[0]; v[5] = b[1]; v[6] = b[2]; v[7] = b[3];
}
__device__ __forceinline__ void ld8f(const float* p, float (&v)[8]) { const f32x4 a = *(const f32x4*)p, b = *(const f32x4*)(p + 4); v[0] = a[0]; v[1] = a[1]; v[2] = a[2]; v[3] = a[3]; v[4] = b[0]; v[5] = b[1]; v[6] = b[2]; v[7] = b[3]; }
__device__ __forceinline__ void st8f(float* p, const float (&v)[8]) { *(f32x4*)p = (f32x4){v[0], v[1], v[2], v[3]}; *(f32x4*)(p + 4) = (f32x4){v[4], v[5], v[6], v[7]}; }
__device__ __forceinline__ void ld8b(const bf16_t* p, float (&v)[8]) { unpack8(*(const u32x4*)p, v); }
__device__ __forceinline__ void st8b(bf16_t* p, const float (&v)[8]) { *(u32x4*)p = pack8(v); }
__device__ __forceinline__ float fq_sum(float s) { s += __shfl_xor(s, 16); s += __shfl_xor(s, 32); return s; }

__device__ __forceinline__ float rot_prev(float v) { return __builtin_bit_cast(float, __builtin_amdgcn_update_dpp(0, __builtin_bit_cast(int, v), 0x121, 0xf, 0xf, false)); }
__device__ __forceinline__ float rot_next(float v) { return __builtin_bit_cast(float, __builtin_amdgcn_update_dpp(0, __builtin_bit_cast(int, v), 0x12f, 0xf, 0xf, false)); }
struct EpiConv {
    static constexpr bool PERM = true, AFTER_DRAIN = false, KSCALE = false;
    bf16_t* out; int ldc; const float* cw; const float* cb; int nconv_tiles;
    float* small; const float* par;
    LAS float* xl;
    __device__ __forceinline__ void operator()(ACC_T, const Unit& u, int wr, int wc, int fr_in, int fq_in) const {
        int fr = fr_in, fq = fq_in; asm volatile("" : "+v"(fr), "+v"(fq));
        const int lane = fr + 16 * fq;
        if (u.pn < nconv_tiles) {
            const bool ctx = u.pm >= (M_LAT / BM);
            {
                const int t = threadIdx.x, arr = t >> 7, c2 = 2 * (t & 127);
                const float* src = (arr < 3 ? cw + arr * ldc : cb) + u.pn * BM + c2;
                *(LAS f32x2*)(xl + 2048 + arr * 256 + c2) = *(const f32x2*)src;
            }
            if (ctx) {
#pragma unroll
                for (int ai = 0; ai < 2; ++ai) { const int g = 2 * ai + wr;
#pragma unroll
                    for (int bj = 0; bj < 2; ++bj) { const int c = 128 * bj + 32 * wc + 8 * fq; float v[8];
                        if (fr == 0) { acc8(acc, ai, bj, 0, v);
#pragma unroll
                            for (int e = 0; e < 8; ++e) xl[(g * 2 + 0) * 256 + c + e] = v[e]; }
                        if (fr == 15) { acc8(acc, ai, bj, 3, v);
#pragma unroll
                            for (int e = 0; e < 8; ++e) xl[(g * 2 + 1) * 256 + c + e] = v[e]; } } }
            }
            asm volatile("s_waitcnt vmcnt(0) lgkmcnt(0)" ::: "memory"); __builtin_amdgcn_s_barrier(); asm volatile("" ::: "memory");
#pragma unroll
            for (int bj = 0; bj < 2; ++bj) {
                const int ct = 128 * bj + 32 * wc + 8 * fq, c0 = u.pn * BM + ct;
#pragma unroll
                for (int ai = 0; ai < 2; ++ai) {
                    const int g = 2 * ai + wr;
                    unsigned pk[4][4];
#pragma unroll
                    for (int hf = 0; hf < 2; ++hf) {
                        const LAS float* wl = xl + 2048 + ct + 4 * hf; const f32x4 w0 = *(const LAS f32x4*)wl, w1 = *(const LAS f32x4*)(wl + 256), w2 = *(const LAS f32x4*)(wl + 512), bb = *(const LAS f32x4*)(wl + 768);
                        f32x4 bp = {0.f, 0.f, 0.f, 0.f}, bn = {0.f, 0.f, 0.f, 0.f};
                        if (ctx) {
                            if (g > 0 && fr == 0) bp = *(const LAS f32x4*)(xl + ((g - 1) * 2 + 1) * 256 + ct + 4 * hf);
                            if (g < 3 && fr == 15) bn = *(const LAS f32x4*)(xl + ((g + 1) * 2 + 0) * 256 + ct + 4 * hf);
                        }
                        f32x4 Rm1 = bp, Xc = acc[ai][bj][0][hf], Lc;
#pragma unroll
                        for (int e = 0; e < 4; ++e) Lc[e] = rot_next(Xc[e]);
#pragma unroll
                        for (int m = 0; m < 4; ++m) {
                            f32x4 Rc, Ln = bn, Xn = Xc, o;
                            if (m < 3) Xn = acc[ai][bj][m < 3 ? m + 1 : 3][hf];
#pragma unroll
                            for (int e = 0; e < 4; ++e) { Rc[e] = rot_prev(Xc[e]); if (m < 3) Ln[e] = rot_next(Xn[e]); }
#pragma unroll
                            for (int e = 0; e < 4; ++e) {
                                const float pv = (fr > 0) ? Rc[e] : Rm1[e];
                                const float nv = (fr < 15) ? Lc[e] : Ln[e];
                                o[e] = siluf_(bb[e] + w0[e] * pv + w1[e] * Xc[e] + w2[e] * nv);
                            }
                            pk[m][2 * hf] = cvt_pk_bf16(o[0], o[1]); pk[m][2 * hf + 1] = cvt_pk_bf16(o[2], o[3]);
                            Rm1 = Rc; Lc = Ln; Xc = Xn;
                        }
                    }
#pragma unroll
                    for (int m = 0; m < 4; ++m) { const size_t row = (size_t)u.pm * BM + ai * HALF + wr * 64 + m * 16 + fr;
                        *(u32x4*)(out + row * ldc + c0) = (u32x4){pk[m][0], pk[m][1], pk[m][2], pk[m][3]}; }
                }
            }
        } else {
            if (wc < 3) {
                const int c0 = 32 * wc + 8 * fq; const bool is_beta = (c0 >= 16) && (c0 < 32);
                float p0[8], p1[8]; ld8f(par + c0, p0); ld8f(par + 96 + c0, p1);
                EPI_FOR_AI_M {
                    float v[8], o[8]; acc8(acc, ai, 0, m, v);
#pragma unroll
                    for (int e = 0; e < 8; ++e) o[e] = is_beta ? sigmoidf_(v[e]) : p0[e] * softplusf_(v[e] + p1[e]);
                    const size_t row = (size_t)u.pm * BM + ai * HALF + wr * 64 + m * 16 + fr;
                    st8f(small + row * SMALL_LD + c0, o);
                }
            }
        }
    }
};

struct EpiZ {
    static constexpr bool PERM = true, AFTER_DRAIN = false, KSCALE = false;
    bf16_t* of; const bf16_t* ob; const float* ost; const float* gnw;
    bf16_t* y; float* ps;
    bf16_t* gates;
    __device__ __forceinline__ void operator()(ACC_T, const Unit& u, int wr, int wc, int fr, int fq) const {
        const size_t row0 = (size_t)u.pm * BM + wr * 64 + fr;
        if (u.pn < 4) {
#pragma unroll
            for (int bj = 0; bj < 2; ++bj) {
                const int c0 = u.pn * BM + 128 * bj + 32 * wc + 8 * fq, head = 2 * u.pn + bj; float w[8]; ld8f(gnw + (c0 & 127), w);
#pragma unroll
                for (int hf = 0; hf < 2; ++hf) {
                    u32x4 a[4], b[4]; float rs[4];
#pragma unroll
                    for (int m = 0; m < 4; ++m) { const size_t row = row0 + hf * HALF + m * 16; a[m] = *(const u32x4*)(of + row * 1024 + c0); b[m] = *(const u32x4*)(ob + row * 1024 + c0); rs[m] = ost[row * 8 + head]; }
#pragma unroll
                    for (int m = 0; m < 4; ++m) { const size_t row = row0 + hf * HALF + m * 16;
                        float z[8], fa[8], fb[8], o[8]; acc8(acc, hf, bj, m, z); unpack8(a[m], fa); unpack8(b[m], fb);
#pragma unroll
                        for (int e = 0; e < 8; ++e) o[e] = (fa[e] + fb[e]) * rs[m] * w[e] * siluf_(z[e]);
                        st8b(of + row * 1024 + c0, o); }
                }
            }
        } else if (u.pn < 12) {
#pragma unroll
            for (int bj = 0; bj < 2; ++bj) {
                const int c0 = (u.pn - 4) * BM + 128 * bj + 32 * wc + 8 * fq;
                u32x4 a[8];
#pragma unroll
                for (int g = 0; g < 8; ++g) { const size_t row = row0 + (g >> 2) * HALF + (g & 3) * 16; a[g] = *(const u32x4*)(y + row * 2048 + c0); }
#pragma unroll
                for (int g = 0; g < 8; ++g) { const size_t row = row0 + (g >> 2) * HALF + (g & 3) * 16;
                    float z[8], fa[8], o[8]; acc8(acc, g >> 2, bj, g & 3, z); unpack8(a[g], fa);
                    float sq = 0.f;
#pragma unroll
                    for (int e = 0; e < 8; ++e) { o[e] = fa[e] * siluf_(z[e]); sq += o[e] * o[e]; }
                    st8b(y + row * 2048 + c0, o);
                    sq = fq_sum(sq);
                    if (fq == 0) ps[row * 64 + (c0 >> 5)] = sq; }
            }
        } else {
#pragma unroll
            for (int bj = 0; bj < 2; ++bj) {
                const int c0 = (u.pn - 12) * BM + 128 * bj + 32 * wc + 8 * fq;
                EPI_FOR_AI_M {
                    const size_t row = (size_t)u.pm * BM + ai * HALF + wr * 64 + m * 16 + fr;
                    float z[8], o[8]; acc8(acc, ai, bj, m, z);
#pragma unroll
                    for (int e = 0; e < 8; ++e) o[e] = sigmoidf_(z[e]);
                    st8b(gates + row * 2048 + c0, o);
                }
            }
        }
    }
};

template <int SECOND> struct EpiBR {
    static constexpr bool PERM = true, AFTER_DRAIN = false, KSCALE = SECOND != 0;
    const bf16_t* gates; bf16_t* m1; bf16_t* merged; const float* rat;
    __device__ __forceinline__ void kscale(f32x4 (&acc)[2][2][4][2], const Unit& u, int g, int wr, int fr) const {
#pragma unroll
        for (int ai = 0; ai < 2; ++ai)
#pragma unroll
            for (int m = 0; m < 4; ++m) { const float r = rat[((size_t)u.pm * BM + ai * HALF + wr * 64 + m * 16 + fr) * 4 + (g - 1)];
#pragma unroll
                for (int bj = 0; bj < 2; ++bj)
#pragma unroll
                    for (int n = 0; n < 2; ++n) acc[ai][bj][m][n] = acc[ai][bj][m][n] * r; }
    }
    __device__ __forceinline__ void operator()(ACC_T, const Unit& u, int wr, int wc, int fr, int fq) const {
        const size_t row0 = (size_t)u.pm * BM + wr * 64 + fr;
#pragma unroll
        for (int bj = 0; bj < 2; ++bj) {
            const int c0 = u.pn * BM + 128 * bj + 32 * wc + 8 * fq;
#pragma unroll
            for (int hf = 0; hf < 2; ++hf) {
                u32x4 gv[4], av[4];
#pragma unroll
                for (int m = 0; m < 4; ++m) { const size_t row = row0 + hf * HALF + m * 16; gv[m] = *(const u32x4*)(gates + row * 2048 + (SECOND ? 1024 : 0) + c0); if (SECOND) av[m] = *(const u32x4*)(m1 + row * 1024 + c0); }
#pragma unroll
                for (int m = 0; m < 4; ++m) { const size_t row = row0 + hf * HALF + m * 16;
                    float p[8], gg[8], o[8]; acc8(acc, hf, bj, m, p); unpack8(gv[m], gg);
                    if (SECOND) { float a[8]; unpack8(av[m], a); const float r3 = rat[row * 4 + 3];
#pragma unroll
                        for (int e = 0; e < 8; ++e) o[e] = a[e] + gg[e] * (p[e] * r3);
                        st8b(merged + row * 1024 + c0, o);
                    } else {
#pragma unroll
                        for (int e = 0; e < 8; ++e) o[e] = gg[e] * p[e];
                        st8b(m1 + row * 1024 + c0, o);
                    } }
            }
        }
    }
};

template <bool IN_BF, bool OUT_BF> struct EpiRes {
    static constexpr bool PERM = true, AFTER_DRAIN = false, KSCALE = false;
    const void* base_; void* out_; const float* gate; float* ps;
    __device__ __forceinline__ void operator()(ACC_T, const Unit& u, int wr, int wc, int fr, int fq) const {
        const int b = u.pm / (SEQ / BM); const size_t row0 = (size_t)u.pm * BM + wr * 64 + fr;
#pragma unroll
        for (int bj = 0; bj < 2; ++bj) {
            const int c0 = u.pn * BM + 128 * bj + 32 * wc + 8 * fq; float g[8]; ld8f(gate + (size_t)b * 6144 + c0, g);
#pragma unroll
            for (int hf = 0; hf < 2; ++hf) {
                f32x4 x0[4], x1[4];
#pragma unroll
                for (int m = 0; m < 4; ++m) { const size_t row = row0 + hf * HALF + m * 16;
                    if constexpr (IN_BF) { float t[8]; ld8b((const bf16_t*)base_ + row * 1024 + c0, t); x0[m] = (f32x4){t[0], t[1], t[2], t[3]}; x1[m] = (f32x4){t[4], t[5], t[6], t[7]}; }
                    else { const float* base = (const float*)base_; x0[m] = *(const f32x4*)(base + row * 1024 + c0); x1[m] = *(const f32x4*)(base + row * 1024 + c0 + 4); } }
#pragma unroll
                for (int m = 0; m < 4; ++m) { const size_t row = row0 + hf * HALF + m * 16;
                    float p[8], o[8]; acc8(acc, hf, bj, m, p);
                    float sq = 0.f;
#pragma unroll
                    for (int e = 0; e < 8; ++e) { o[e] = (e < 4 ? x0[m][e & 3] : x1[m][e & 3]) + g[e] * p[e]; sq += o[e] * o[e]; }
                    if constexpr (OUT_BF) st8b((bf16_t*)out_ + row * 1024 + c0, o); else st8f((float*)out_ + row * 1024 + c0, o);
                    sq = fq_sum(sq);
                    if (fq == 0) ps[row * 32 + (c0 >> 5)] = sq; }
            }
        }
    }
};

struct EpiFF1 {
    static constexpr bool PERM = true, AFTER_DRAIN = false, KSCALE = false;
    bf16_t* act;
    __device__ __forceinline__ void operator()(ACC_T, const Unit& u, int wr, int wc, int fr, int fq) const {
        const int c0 = u.pn * 128 + 32 * wc + 8 * fq;
        EPI_FOR_AI_M {
            const size_t row = (size_t)u.pm * BM + ai * HALF + wr * 64 + m * 16 + fr;
            float g[8], up[8], o[8]; acc8(acc, ai, 0, m, g); acc8(acc, ai, 1, m, up);
#pragma unroll
            for (int e = 0; e < 8; ++e) o[e] = siluf_(g[e]) * up[e];
            st8b(act + row * DFF + c0, o);
        }
    }
};

struct EpiP {
    static constexpr bool PERM = true, AFTER_DRAIN = false, KSCALE = false;
    bf16_t* out; const float* gate;
    __device__ __forceinline__ void operator()(ACC_T, const Unit& u, int wr, int wc, int fr, int fq) const {
        const int b = u.pm / (SEQ / BM);
#pragma unroll
        for (int bj = 0; bj < 2; ++bj) {
            const int c0 = u.pn * BM + 128 * bj + 32 * wc + 8 * fq; float g[8]; ld8f(gate + (size_t)b * 6144 + c0, g);
            EPI_FOR_AI_M {
                const size_t row = (size_t)u.pm * BM + ai * HALF + wr * 64 + m * 16 + fr;
                float p[8], o[8]; acc8(acc, ai, bj, m, p);
#pragma unroll
                for (int e = 0; e < 8; ++e) o[e] = g[e] * p[e];
                st8b(out + row * 1024 + c0, o);
            }
        }
    }
};

struct EpiNull {
    static constexpr bool PERM = true, AFTER_DRAIN = false, KSCALE = false;
    __device__ __forceinline__ void operator()(ACC_T, const Unit& u, int wr, int wc, int fr, int fq) const {
#pragma unroll
        for (int ai = 0; ai < 2; ++ai)
#pragma unroll
            for (int bj = 0; bj < 2; ++bj)
#pragma unroll
                for (int m = 0; m < 4; ++m) { asm volatile("" :: "v"(acc[ai][bj][m][0])); asm volatile("" :: "v"(acc[ai][bj][m][1])); }
    }
};

struct Args {
    const float* in[26];
    float* out; unsigned char* ws;
    int ph_lo, ph_hi;
};
enum In { I_X = 0, I_C, I_CTX, I_CCTX, I_ADAW, I_ADAB, I_N1W, I_WIN, I_GCW, I_GCB, I_GALOG, I_GDTB, I_GNW, I_SCW, I_SCB, I_SALOG, I_SDTB, I_SD, I_SNW, I_WBG, I_WBS, I_WO, I_N2W, I_WF1, I_WF2, I_NFW };

#define KARG_PTR(off) (*(const unsigned long long volatile __attribute__((address_space(4)))*)((const __attribute__((address_space(4))) char*)__builtin_amdgcn_kernarg_segment_ptr() + (off)))
#define GAS __attribute__((address_space(1)))
#define KIN(i) ((const float*)(const GAS float*)KARG_PTR(8 * (i)))
#define KOUT() ((float*)(GAS float*)KARG_PTR(208))
#define KWS() ((unsigned char*)(GAS unsigned char*)KARG_PTR(216))
#define LDS_WAIT() asm volatile("s_waitcnt lgkmcnt(0)" ::: "memory")

#define XB_TMO      128
#define XB_XCNT(j)  (256  + 64 * (j))
#define XB_XSUB(j)  (1280 + 64 * (j))
#define XB_XGEN(j)  (2304 + 64 * (j))
#define XB_TOP      3328
#define XB_TOPGEN   3392
#define XCD_BAR_WORDS 3456
#define XB_SPIN_CAP (1u << 18)

__device__ __forceinline__ unsigned xb_ld(unsigned* p)              { return __hip_atomic_load(p, __ATOMIC_RELAXED, __HIP_MEMORY_SCOPE_AGENT); }
__device__ __forceinline__ unsigned xb_add(unsigned* p, unsigned v) { return __hip_atomic_fetch_add(p, v, __ATOMIC_RELAXED, __HIP_MEMORY_SCOPE_AGENT); }
__device__ __forceinline__ unsigned xb_xcc_id() { return (unsigned)__builtin_amdgcn_s_getreg((3 << 11) | 20) & 0xFu; }
#define XB_SPIN(cond, bar) do { unsigned _sp = 0; while (cond) { __builtin_amdgcn_s_sleep(1); \
    if ((++_sp & 255u) == 0u) { if (xb_ld(&(bar)[XB_TMO])) break; if (_sp > XB_SPIN_CAP) { atomicAdd(&(bar)[XB_TMO], 1u); break; } } } } while (0)

struct XcdBarrier {
    unsigned* bar; unsigned x;
    volatile LAS unsigned* st;
};

__device__ __forceinline__ XcdBarrier xcd_barrier_post(unsigned* bar, volatile LAS unsigned* st) {
    XcdBarrier b; b.bar = bar; b.x = xb_xcc_id(); b.st = st;
    if (threadIdx.x == 0) (void)xb_add(&bar[XB_XCNT(b.x)], 1u);
    return b;
}
__device__ __forceinline__ void xcd_barrier_complete(unsigned* bar, unsigned x, unsigned& nloc, unsigned& nx) {
    const unsigned G = gridDim.x * gridDim.y * gridDim.z;
    unsigned sum, cnt, mine, sp = 0u;
    for (;;) {
        sum = 0u; cnt = 0u; mine = 0u;
#pragma unroll
        for (unsigned j = 0; j < 16; ++j) { const unsigned c = xb_ld(&bar[XB_XCNT(j)]); sum += c; cnt += (c > 0u) ? 1u : 0u; mine = (j == x) ? c : mine; }
        if (sum == G) break;
        __builtin_amdgcn_s_sleep(1);
        if ((++sp & 255u) == 0u) { if (xb_ld(&bar[XB_TMO])) break; if (sp > XB_SPIN_CAP) { atomicAdd(&bar[XB_TMO], 1u); break; } }
    }
    nloc = mine > 0u ? mine : 1u; nx = cnt > 0u ? cnt : 1u;
}

__device__ __forceinline__ void xcd_barrier(const XcdBarrier& b) {
    asm volatile("s_waitcnt vmcnt(0)" ::: "memory");
    __syncthreads();
    if (threadIdx.x == 0) {
        unsigned* bar = b.bar;
        __builtin_amdgcn_s_waitcnt(0);
        unsigned nloc = b.st[0], nx = b.st[1];
        if (nloc == 0u) { xcd_barrier_complete(bar, b.x, nloc, nx); b.st[0] = nloc; b.st[1] = nx; }
        const unsigned old = xb_add(&bar[XB_XSUB(b.x)], 1u);
        const unsigned gen = old / nloc;
        if (old + 1u == (gen + 1u) * nloc) {
            __builtin_amdgcn_fence(__ATOMIC_RELEASE, "agent");
            asm volatile("s_waitcnt vmcnt(0)" ::: "memory");
            const unsigned og = xb_add(&bar[XB_TOP], 1u);
            const unsigned tg = og / nx;
            if (og + 1u == (tg + 1u) * nx) xb_add(&bar[XB_TOPGEN], 1u);
            else XB_SPIN(xb_ld(&bar[XB_TOPGEN]) == tg, bar);
            __builtin_amdgcn_fence(__ATOMIC_ACQUIRE, "agent");
            xb_add(&bar[XB_XGEN(b.x)], 1u);
            asm volatile("s_waitcnt vmcnt(0)" ::: "memory");
        } else {
            XB_SPIN(xb_ld(&bar[XB_XGEN(b.x)]) == gen, bar);
            __builtin_amdgcn_fence(__ATOMIC_ACQUIRE, "agent");
            asm volatile("s_waitcnt vmcnt(0)" ::: "memory");
        }
    }
    __syncthreads();
}

__device__ __forceinline__ f32x4 mma16(bf16x8 a, bf16x8 b, f32x4 c) { return __builtin_amdgcn_mfma_f32_16x16x32_bf16(a, b, c, 0, 0, 0); }
__device__ __forceinline__ bf16x8 frag_std(const LAS bf16_t* X, int pitch, int r0, int c0, int lane) {
    return *(const LAS bf16x8*)(X + (r0 + (lane & 15)) * pitch + c0 + 8 * (lane >> 4));
}
__device__ __forceinline__ bf16x8 frag_perm(const LAS bf16_t* X, int pitch, int r0, int c0, int lane) {
    const LAS bf16_t* p = X + (r0 + (lane & 15)) * pitch + c0 + 4 * (lane >> 4);
    const bf16x4 a = *(const LAS bf16x4*)p, b = *(const LAS bf16x4*)(p + 16);
    return (bf16x8){a[0], a[1], a[2], a[3], b[0], b[1], b[2], b[3]};
}
__device__ __forceinline__ bf16x8 acc_frag(f32x4 lo, f32x4 hi) {
    u32x4 w; w.x = cvt_pk_bf16(lo[0], lo[1]); w.y = cvt_pk_bf16(lo[2], lo[3]); w.z = cvt_pk_bf16(hi[0], hi[1]); w.w = cvt_pk_bf16(hi[2], hi[3]);
    return __builtin_bit_cast(bf16x8, w);
}
__device__ __forceinline__ int chunk_row0(int ci) { return ci < NCH_LAT ? ci * 64 : M_LAT + (ci - NCH_LAT) * 64; }

__device__ __forceinline__ void transpose_item(const float* W, int Nsrc, int K, int src_c0, bf16_t* WT, int dst_r0, LAS float* scr, int kb, int lane, const float* kscale = nullptr) {
    const int k0 = 64 * kb;
#pragma unroll 8
    for (int i = 0; i < 32; ++i) { const int kk = 2 * i + (lane >> 5); scr[kk * 33 + (lane & 31)] = W[(size_t)(k0 + kk) * Nsrc + src_c0 + (lane & 31)] * (kscale ? kscale[k0 + kk] : 1.0f); }
    LDS_WAIT(); asm volatile("" ::: "memory");
    const int c = lane & 7;
#pragma unroll
    for (int j = 0; j < 4; ++j) { const int n = (lane >> 3) + 8 * j; const LAS float* s = scr + (8 * c) * 33 + n;
        u32x4 o; o.x = cvt_pk_bf16(s[0 * 33], s[1 * 33]); o.y = cvt_pk_bf16(s[2 * 33], s[3 * 33]); o.z = cvt_pk_bf16(s[4 * 33], s[5 * 33]); o.w = cvt_pk_bf16(s[6 * 33], s[7 * 33]);
        *(u32x4*)(WT + (size_t)(dst_r0 + n) * K + k0 + 8 * c) = o; }
    LDS_WAIT(); asm volatile("" ::: "memory");
}
__device__ __forceinline__ bool seg_item(int& it, const float* W, int Nsrc, int K, int src_c0, bf16_t* WT, int dst_r0, int ncols, LAS float* scr, int lane, const float* kscale = nullptr) {
    const int nblk = ncols / 32, n_items = (K / 64) * nblk;
    if (it >= n_items) { it -= n_items; return false; }
    const int kb = it / nblk, nb = it % nblk;
    transpose_item(W, Nsrc, K, src_c0 + 32 * nb, WT, dst_r0 + 32 * nb, scr, kb, lane, kscale);
    return true;
}
constexpr int N_ITEMS_W1A = 16 * ((3072 + 32 + 64) / 32);
constexpr int N_ITEMS_ALL = 16 * (D_IN / 32) + 16 * 32 + 32 * 32 + 16 * 32 + 16 * (NF1 / 32) + 44 * 32;
__device__ __forceinline__ void weight_convert(LAS unsigned char* lds, int item_lo, int item_hi, int gw, int NGW) {
    const int lane = threadIdx.x & 63, wave = threadIdx.x >> 6; unsigned char* ws = KWS();
    LAS float* scr = (LAS float*)(lds + wave * 8704);
    const float* win = KIN(I_WIN);
    bf16_t* W1A = (bf16_t*)(ws + WS_W1A); bf16_t* W1B = (bf16_t*)(ws + WS_W1B); bf16_t* WZ = (bf16_t*)(ws + WS_WZ);
    bf16_t* WBG = (bf16_t*)(ws + WS_WBG); bf16_t* WBS = (bf16_t*)(ws + WS_WBS); bf16_t* WO = (bf16_t*)(ws + WS_WO);
    bf16_t* WF1 = (bf16_t*)(ws + WS_WF1); bf16_t* WF2 = (bf16_t*)(ws + WS_WF2);
    for (int it0 = item_lo + gw; it0 < item_hi; it0 += NGW) {
        int it = it0;
        if (seg_item(it, win, D_IN, 1024, 0, W1A, 0, 3072, scr, lane)) continue;
        if (seg_item(it, win, D_IN, 1024, 4096, W1A, 3072, 32, scr, lane)) continue;
        if (seg_item(it, win, D_IN, 1024, 9248, W1A, 3104, 64, scr, lane)) continue;
        if (seg_item(it, win, D_IN, 1024, 6176, W1B, 0, 3072, scr, lane)) continue;
        if (seg_item(it, win, D_IN, 1024, 3072, WZ, 0, 1024, scr, lane)) continue;
        if (seg_item(it, win, D_IN, 1024, 4128, WZ, 1024, 2048, scr, lane)) continue;
        if (seg_item(it, win, D_IN, 1024, 9312, WZ, 3072, 2048, scr, lane)) continue;
        if (seg_item(it, KIN(I_WBG), 1024, 1024, 0, WBG, 0, 1024, scr, lane)) continue;
        if (seg_item(it, KIN(I_WBS), 1024, 2048, 0, WBS, 0, 1024, scr, lane, KIN(I_SNW))) continue;
        if (seg_item(it, KIN(I_WO), 1024, 1024, 0, WO, 0, 1024, scr, lane)) continue;
        if (it < 16 * (NF1 / 32)) {
            const int nblk = NF1 / 32, kb = it / nblk, db = it % nblk, pn = db >> 3, wi = db & 7;
            const int src = (wi < 4) ? (128 * pn + 32 * wi) : (DFF + 128 * pn + 32 * (wi - 4));
            transpose_item(KIN(I_WF1), NF1, 1024, src, WF1, 32 * db, scr, kb, lane); continue; }
        it -= 16 * (NF1 / 32);
        seg_item(it, KIN(I_WF2), 1024, DFF, 0, WF2, 0, 1024, scr, lane);
    }
}
__device__ __forceinline__ void p0_prologue(const Args& a, LAS unsigned char* lds) {
    const int tid = threadIdx.x, lane = tid & 63, wave = tid >> 6, G = gridDim.x;
    unsigned char* ws = KWS();
    if (blockIdx.x < 96) {
        LAS float* cs = (LAS float*)(lds + 81920);
        LAS float* red = (LAS float*)(lds + 81920 + 20480);
        for (int idx = tid; idx < 5 * 1024; idx += 512) { const int r = idx >> 10, k = idx & 1023; const float v = r < 4 ? KIN(I_C)[r * 1024 + k] : KIN(I_CCTX)[k]; cs[idx] = v / (1.f + expf(-v)); }
        __syncthreads();
        const int col = 64 * blockIdx.x + lane; const float* aw = KIN(I_ADAW);
        float acc[5] = {0.f, 0.f, 0.f, 0.f, 0.f};
        for (int k0 = 128 * wave; k0 < 128 * wave + 128; k0 += 32) {
            float wv[32];
#pragma unroll
            for (int j = 0; j < 32; ++j) wv[j] = aw[(size_t)(k0 + j) * 6144 + col];
#pragma unroll
            for (int j = 0; j < 32; ++j)
#pragma unroll
                for (int r = 0; r < 5; ++r) acc[r] += cs[r * 1024 + k0 + j] * wv[j]; }
#pragma unroll
        for (int r = 0; r < 5; ++r) red[(wave * 5 + r) * 64 + lane] = acc[r];
        __syncthreads();
        if (wave == 0) { float* mod = (float*)(ws + WS_MOD); const float bias = KIN(I_ADAB)[col];
#pragma unroll
            for (int r = 0; r < 5; ++r) { float s = bias;
#pragma unroll
                for (int w = 0; w < 8; ++w) s += red[(w * 5 + r) * 64 + lane];
                mod[r * 6144 + col] = s; } }
        __syncthreads();
    }
    if (blockIdx.x == 96 && tid < 96) {
        float* par = (float*)(ws + WS_PAR); float p0, p1;
        if (tid < 16) { p0 = -expf(KIN(I_GALOG)[tid]); p1 = KIN(I_GDTB)[tid]; } else if (tid < 32) { p0 = 0.f; p1 = 0.f; } else { p0 = 1.f; p1 = KIN(I_SDTB)[tid - 32]; }
        par[tid] = p0; par[96 + tid] = p1; }
    if (blockIdx.x >= 96) weight_convert(lds, 0, N_ITEMS_W1A, (blockIdx.x - 96) * 8 + wave, (G - 96) * 8);
    bf16_t* W1A = (bf16_t*)(ws + WS_W1A);
    { u32x4* z = (u32x4*)(W1A + (size_t)3168 * 1024); const int n16 = 160 * 1024 * 2 / 16;
      for (int i = blockIdx.x * 512 + tid; i < n16; i += G * 512) z[i] = (u32x4){0u, 0u, 0u, 0u}; }
}

__device__ __forceinline__ void p1_norm_mod(const Args& a) {
    const int lane = threadIdx.x & 63, wave = threadIdx.x >> 6; const int gw = blockIdx.x * 8 + wave, NGW = gridDim.x * 8;
    const float* mod = (const float*)(KWS() + WS_MOD); bf16_t* A = (bf16_t*)(KWS() + WS_A); const float* X = KIN(I_X); const float* CX = KIN(I_CTX);
    for (int bt = gw; bt < M_ALL / 4; bt += NGW) {
        const int row0 = 4 * bt; const float* src = row0 < M_LAT ? X + (size_t)row0 * 1024 : CX + (size_t)(row0 - M_LAT) * 1024; const int r = row0 < M_LAT ? row0 / SEQ : 4;
        f32x4 v[4][4];
#pragma unroll
        for (int i = 0; i < 4; ++i)
#pragma unroll
            for (int j = 0; j < 4; ++j) v[i][j] = *(const f32x4*)(src + (size_t)i * 1024 + 4 * lane + 256 * j);
        f32x4 sc[4], sh[4];
#pragma unroll
        for (int j = 0; j < 4; ++j) { const int c = 4 * lane + 256 * j; const f32x4 w = *(const f32x4*)(KIN(I_N1W) + c), s1 = *(const f32x4*)(mod + r * 6144 + 1024 + c);
            sc[j] = w * (s1 + 1.0f); sh[j] = *(const f32x4*)(mod + r * 6144 + c); }
#pragma unroll
        for (int i = 0; i < 4; ++i) { float ss = 0.f;
#pragma unroll
            for (int j = 0; j < 4; ++j) ss += (v[i][j][0] * v[i][j][0] + v[i][j][1] * v[i][j][1]) + (v[i][j][2] * v[i][j][2] + v[i][j][3] * v[i][j][3]);
            const float rstd = rsqrtf(wave_sum(ss) * (1.f / 1024.f) + EPS);
#pragma unroll
            for (int j = 0; j < 4; ++j) { const f32x4 o = v[i][j] * rstd * sc[j] + sh[j]; u32x2 w; w.x = cvt_pk_bf16(o[0], o[1]); w.y = cvt_pk_bf16(o[2], o[3]);
                *(u32x2*)(A + (size_t)(row0 + i) * 1024 + 4 * lane + 256 * j) = w; } }
    }
}

constexpr int GCV = 264;
constexpr int KP = 136, TP = 72;
__device__ __forceinline__ f32x4 mma4f(float a, float b, f32x4 c) { return __builtin_amdgcn_mfma_f32_16x16x4f32(a, b, c, 0, 0, 0); }
template <int V> __device__ __forceinline__ void gdn_prep_phase(LAS unsigned char* lds) {
    const int tid = threadIdx.x, lane = tid & 63, wave = __builtin_amdgcn_readfirstlane(tid >> 6), n = lane & 15, q = lane >> 4;
    bf16_t* QKV = (bf16_t*)(KWS() + WS_QKV); const float* SM = (const float*)(KWS() + WS_SMALL);
    float* GC = (float*)(KWS() + ((V & 8) ? 472 * MiB : WS_GC)); bf16_t* TA = (V & 8) ? (bf16_t*)KOUT() : (bf16_t*)(KWS() + WS_TA);
    LAS bf16_t* Ks = (LAS bf16_t*)lds;
    LAS bf16_t* Qs = Ks + 64 * KP;
    LAS float* As = (LAS float*)lds;
    LAS float* KK = (LAS float*)(lds + 34816);
    LAS float* QK = KK + 64 * 68;
    LAS float* Tf = KK;
    LAS bf16_t* Ps = (LAS bf16_t*)(lds + 2 * 34816);
    LAS float* Rs = (LAS float*)(lds + 2 * 34816 + 36864);
    LAS float* gcs = Rs + 2 * 16 * 68;
    LAS float* bts = gcs + 128;
    LAS float* rks = bts + 128;
    LAS float* rqs = rks + 64;
    float gsave = 0.f, bsave = 0.f;
    const int row = tid >> 3, seg = tid & 7;
    u32x4 pq0, pq1, pk0, pk1; float pg = 0.f, pb = 0.f;
#define PREP_ISSUE(unit_) do { const int ci_ = (unit_) >> 3, h_ = (unit_) & 7, row0_ = chunk_row0(ci_); \
        const bf16_t* qp_ = QKV + (size_t)(row0_ + row) * QKV_LD + 128 * h_ + 16 * seg; pq0 = *(const u32x4*)qp_; pq1 = *(const u32x4*)(qp_ + 8); pk0 = *(const u32x4*)(qp_ + 1024); pk1 = *(const u32x4*)(qp_ + 1032); \
        if (wave < 2) { const int srow_ = row0_ + (wave ? 63 - lane : lane); pg = SM[(size_t)srow_ * SMALL_LD + 8 * wave + h_]; pb = SM[(size_t)srow_ * SMALL_LD + 16 + 8 * wave + h_]; } } while (0)
    int unit = blockIdx.x;
    if (unit < NCH * 8) PREP_ISSUE(unit);
    for (; unit < NCH * 8; unit += gridDim.x) {
        const int ci = unit >> 3, h = unit & 7, row0 = chunk_row0(ci);
        {
          float q0[8], q1[8], k0[8], k1[8]; unpack8(pq0, q0); unpack8(pq1, q1); unpack8(pk0, k0); unpack8(pk1, k1);
          float sq = 0.f, sk = 0.f;
#pragma unroll
          for (int e = 0; e < 8; ++e) { sq += q0[e] * q0[e] + q1[e] * q1[e]; sk += k0[e] * k0[e] + k1[e] * k1[e]; }
          sq += __shfl_xor(sq, 1); sq += __shfl_xor(sq, 2); sq += __shfl_xor(sq, 4);
          sk += __shfl_xor(sk, 1); sk += __shfl_xor(sk, 2); sk += __shfl_xor(sk, 4);
          const float rq = rsqrtf(sq + EPS) * 0.08838834764831845f, rk = rsqrtf(sk + EPS);
#pragma unroll
          for (int e = 0; e < 8; ++e) { q0[e] *= rq; q1[e] *= rq; k0[e] *= rk; k1[e] *= rk; }
          const u32x4 wq0 = pack8(q0), wq1 = pack8(q1), wk0 = pack8(k0), wk1 = pack8(k1);
          if (seg == 0) { rks[row] = rk; rqs[row] = rq; }
          *(LAS u32x4*)(Qs + row * KP + 16 * seg) = wq0; *(LAS u32x4*)(Qs + row * KP + 16 * seg + 8) = wq1;
          *(LAS u32x4*)(Ks + row * KP + 16 * seg) = wk0; *(LAS u32x4*)(Ks + row * KP + 16 * seg + 8) = wk1; }
        if (wave < 2) { const int d = wave; float g = pg;
#pragma unroll
            for (int o = 1; o < 64; o <<= 1) { const float t = __shfl_up(g, o); if (lane >= o) g += t; }
            gcs[d * 64 + lane] = g; bts[d * 64 + lane] = pb; gsave = g; bsave = pb; }
        if (unit + (int)gridDim.x < NCH * 8) PREP_ISSUE(unit + gridDim.x);
        __syncthreads();
        if (wave < 2) { const int d = wave, pr = d ? 63 - lane : lane; const float g = gsave, gl = __shfl(g, 63), rkk = rks[pr], rqq = rqs[pr], eg = __expf(g);
            float* gv = GC + ((size_t)(ci * 8 + h) * 2 + d) * GCV; gv[lane] = eg * rkk; gv[64 + lane] = __expf(gl - g) * rkk; gv[128 + lane] = bsave; gv[192 + lane] = eg * rqq; if (lane == 63) gv[256] = eg; }
        if (!(V & 4)) for (int t = wave * 4; t < wave * 4 + 4; ++t) { const int which = t >> 4, mi = (t >> 2) & 3, ni = t & 3;
            const LAS bf16_t* Am = which ? Qs : Ks; f32x4 c = {0.f, 0.f, 0.f, 0.f};
#pragma unroll
            for (int ks = 0; ks < 4; ++ks) c = mma16(frag_std(Am, KP, 16 * mi, 32 * ks, lane), frag_std(Ks, KP, 16 * ni, 32 * ks, lane), c);
            LAS float* D = which ? QK : KK;
#pragma unroll
            for (int r = 0; r < 4; ++r) D[(16 * mi + 4 * q + r) * 68 + 16 * ni + n] = c[r]; }
        __syncthreads();
        { float av[2][8]; u32x4 at[2];
#pragma unroll
          for (int t = 0; t < 2; ++t) { const int item = tid + 512 * t, d = item >> 9, i = (item >> 3) & 63, j8 = item & 7; const int si = d ? 63 - i : i;
            if (V & 2) { for (int e = 0; e < 8; ++e) av[t][e] = 0.f; at[t] = (u32x4){0u, 0u, 0u, 0u}; continue; }
            float kk[8], qk[8], gj[8];
            { const int c0 = d ? 56 - 8 * j8 : 8 * j8; const f32x4 a0 = *(const LAS f32x4*)(KK + si * 68 + c0), a1 = *(const LAS f32x4*)(KK + si * 68 + c0 + 4), b0 = *(const LAS f32x4*)(QK + si * 68 + c0), b1 = *(const LAS f32x4*)(QK + si * 68 + c0 + 4);
              const f32x4 g0 = *(const LAS f32x4*)(gcs + d * 64 + 8 * j8), g1 = *(const LAS f32x4*)(gcs + d * 64 + 8 * j8 + 4);
#pragma unroll
              for (int e = 0; e < 4; ++e) { gj[e] = g0[e]; gj[4 + e] = g1[e];
                  if (d) { kk[e] = a1[3 - e]; kk[4 + e] = a0[3 - e]; qk[e] = b1[3 - e]; qk[4 + e] = b0[3 - e]; } else { kk[e] = a0[e]; kk[4 + e] = a1[e]; qk[e] = b0[e]; qk[4 + e] = b1[e]; } } }
            const float gi = gcs[d * 64 + i], bi = bts[d * 64 + i]; float tt[8];
#pragma unroll
            for (int e = 0; e < 8; ++e) { const int j = 8 * j8 + e; const float dec = (j <= i) ? __expf(gi - gj[e]) : 0.f;
                av[t][e] = (j < i) ? bi * kk[e] * dec : 0.f; tt[e] = qk[e] * dec; }
            at[t] = pack8(tt); }
          __syncthreads();
#pragma unroll
          for (int t = 0; t < 2; ++t) { const int item = tid + 512 * t, d = item >> 9, i = (item >> 3) & 63, j8 = item & 7;
            *(LAS f32x4*)(As + (d * 64 + i) * 68 + 8 * j8) = (f32x4){av[t][0], av[t][1], av[t][2], av[t][3]}; *(LAS f32x4*)(As + (d * 64 + i) * 68 + 8 * j8 + 4) = (f32x4){av[t][4], av[t][5], av[t][6], av[t][7]};
            *(LAS u32x4*)(Ps + ((2 * d + 1) * 64 + i) * TP + 8 * j8) = at[t]; } }
        __syncthreads();
        if (wave < 2 && !(V & 1)) { const int d = wave; const LAS float* Ad = As + d * 64 * 68; LAS float* Td = Tf + d * 64 * 68; LAS float* Rd = Rs + d * 16 * 68;
            {
                float t[16];
#pragma unroll
                for (int r = 0; r < 16; ++r) { float s0 = (r == n) ? 1.f : 0.f, s1 = 0.f;
#pragma unroll
                    for (int j = 0; j < r; ++j) { const float a = Ad[(16 * q + r) * 68 + 16 * q + j]; if (j & 1) s1 -= a * t[j]; else s0 -= a * t[j]; }
                    t[r] = s0 + s1; Td[(16 * q + r) * 68 + 16 * q + n] = t[r]; } }
            asm volatile("s_waitcnt lgkmcnt(0)" ::: "memory");
#pragma unroll
            for (int i = 1; i < 4; ++i) {
#pragma unroll
                for (int j = 0; j < i; ++j) { f32x4 c = {0.f, 0.f, 0.f, 0.f};
#pragma unroll
                    for (int k4 = 4 * j; k4 < 4 * i; ++k4) c = mma4f(Ad[(16 * i + n) * 68 + 4 * k4 + q], Td[(4 * k4 + q) * 68 + 16 * j + n], c);
#pragma unroll
                    for (int r = 0; r < 4; ++r) Rd[(4 * q + r) * 68 + 16 * j + n] = c[r]; }
                asm volatile("s_waitcnt lgkmcnt(0)" ::: "memory");
#pragma unroll
                for (int j = 0; j < i; ++j) { f32x4 c = {0.f, 0.f, 0.f, 0.f};
#pragma unroll
                    for (int k4 = 0; k4 < 4; ++k4) c = mma4f(Td[(16 * i + n) * 68 + 16 * i + 4 * k4 + q], Rd[(4 * k4 + q) * 68 + 16 * j + n], c);
#pragma unroll
                    for (int r = 0; r < 4; ++r) Td[(16 * i + 4 * q + r) * 68 + 16 * j + n] = -c[r]; }
                asm volatile("s_waitcnt lgkmcnt(0)" ::: "memory");
            } }
        __syncthreads();
#pragma unroll
        for (int t = 0; t < 2; ++t) { const int item = tid + 512 * t, d = item >> 9, i = (item >> 3) & 63, j8 = item & 7; float tt[8];
            const f32x4 a0 = *(const LAS f32x4*)(Tf + (d * 64 + i) * 68 + 8 * j8), a1 = *(const LAS f32x4*)(Tf + (d * 64 + i) * 68 + 8 * j8 + 4);
#pragma unroll
            for (int e = 0; e < 8; ++e) { const int j = 8 * j8 + e; const float v = e < 4 ? a0[e & 3] : a1[e & 3]; tt[e] = (j < i) ? v : (j == i ? 1.f : 0.f); }
            *(LAS u32x4*)(Ps + ((2 * d) * 64 + i) * TP + 8 * j8) = pack8(tt); }
        __syncthreads();
        for (int e = tid; e < 2048; e += 512) { const int dm = e >> 9, i = (e >> 3) & 63, c8 = e & 7;
            *(u32x4*)(TA + ((((size_t)(ci * 8 + h) * 4 + dm) * 4096 + i * 64 + 8 * c8) & ((V & 8) ? (size_t)0x3ffffff : ~(size_t)0))) = *(const LAS u32x4*)(Ps + (dm * 64 + i) * TP + 8 * c8); }
        __syncthreads();
    }
#undef PREP_ISSUE
}

typedef short v4i16_t __attribute__((ext_vector_type(4)));
__device__ __forceinline__ bf16x4 tr4(const LAS bf16_t* p) { return __builtin_bit_cast(bf16x4, __builtin_amdgcn_ds_read_tr16_b64_v4i16((LAS v4i16_t*)p)); }
__device__ __forceinline__ bf16x8 frag_tr_perm(const LAS bf16_t* X, int pitch, int r0, int c0, int lane) {
    const int i = lane & 15, q = lane >> 4; const LAS bf16_t* p = X + (r0 + 4 * q + (i >> 2)) * pitch + c0 + 4 * (i & 3);
    const bf16x4 a = tr4(p), b = tr4(p + 16 * pitch); return (bf16x8){a[0], a[1], a[2], a[3], b[0], b[1], b[2], b[3]};
}
__device__ __forceinline__ bf16x8 frag_tr_std(const LAS bf16_t* X, int pitch, int r0, int c0, int lane) {
    const int i = lane & 15, q = lane >> 4; const LAS bf16_t* p = X + (r0 + 8 * q + (i >> 2)) * pitch + c0 + 4 * (i & 3);
    const bf16x4 a = tr4(p), b = tr4(p + 4 * pitch); return (bf16x8){a[0], a[1], a[2], a[3], b[0], b[1], b[2], b[3]};
}
__device__ __forceinline__ int Pmap(int t, int i) { return 32 * (t >> 1) + 8 * (i >> 2) + 4 * (t & 1) + (i & 3); }
__device__ __forceinline__ bf16x8 frag_rowP(const LAS bf16_t* X, int pitch, int t, int c0, int lane) {
    return *(const LAS bf16x8*)(X + Pmap(t, lane & 15) * pitch + c0 + 8 * (lane >> 4));
}
__device__ __forceinline__ bf16x8 frag_trP(const LAS bf16_t* X, int pitch, int r0, int t, int lane) {
    const int i = lane & 15, q = lane >> 4; const LAS bf16_t* p = X + (r0 + 8 * q + (i >> 2)) * pitch + 32 * (t >> 1) + 8 * (i & 3) + 4 * (t & 1);
    const bf16x4 a = tr4(p), b = tr4(p + 4 * pitch); return (bf16x8){a[0], a[1], a[2], a[3], b[0], b[1], b[2], b[3]};
}
__device__ __forceinline__ u32x2 pack4(f32x4 v) { u32x2 w; w.x = cvt_pk_bf16(v[0], v[1]); w.y = cvt_pk_bf16(v[2], v[3]); return w; }
__device__ __forceinline__ f32x4 unpack4(u32x2 w) { return (f32x4){bflo(w.x), bfhi(w.x), bflo(w.y), bfhi(w.y)}; }
__device__ __forceinline__ f32x4 bf4f(bf16x4 v) { return (f32x4){bf2f((bf16_t)v[0]), bf2f((bf16_t)v[1]), bf2f((bf16_t)v[2]), bf2f((bf16_t)v[3])}; }


#define SBAR __builtin_amdgcn_sched_barrier(0);
#define WG_BARRIER() do { asm volatile("s_waitcnt lgkmcnt(0)" ::: "memory"); __builtin_amdgcn_s_barrier(); asm volatile("" ::: "memory"); } while (0)
template <int V> __device__ __forceinline__ void gdn_scan_phase(LAS unsigned char* lds) {
    if (blockIdx.x >= NB * 8 * 2 * 2) {
        if (V == 0) weight_convert(lds, N_ITEMS_W1A, N_ITEMS_ALL, (blockIdx.x - NB * 8 * 2 * 2) * 8 + (threadIdx.x >> 6), (gridDim.x - NB * 8 * 2 * 2) * 8);
        return; }
    const int tid = threadIdx.x, lane = tid & 63, wave = __builtin_amdgcn_readfirstlane(tid >> 6), n = lane & 15, q = lane >> 4;
    const int unit = (blockIdx.x & 7) * 8 + ((blockIdx.x >> 3) >> 1), half = (blockIdx.x >> 3) & 1;
    const int b = unit >> 4, h = (unit >> 1) & 7, d = unit & 1, dvl = 16 * (wave & 3), dv0 = 64 * half + dvl;
    constexpr int BUFB = 2 * 64 * 128 * 2 + 3 * 64 * 64 * 2 + 1280;
#define GSW_K(r_) ((((r_) & 3) << 2) ^ ((((r_) >> 3) & 1) * 3) ^ ((((r_) >> 4) & 1) * 2))
#define GSW_Q(r_) ((r_) & 15)
#define GSW_V(r_) (((((r_) >> 1) & 1) << 1) | ((((r_) >> 3) & 1) << 2))
#define GSW_T(r_) ((((r_) >> 1) & 1) | ((((r_) >> 3) & 1) << 1) | ((((r_) >> 4) & 1) << 2))
#define GSW_A(r_) (((r_) >> 1) & 7)
#define GDN_CHUNK(s_, ci_, row0_) do { if ((s_) < 4) { const int cc_ = d ? 3 - (s_) : (s_); ci_ = NCH_LAT + 4 * b + cc_; row0_ = M_LAT + CTXL * b + 64 * cc_; } \
        else { const int cc_ = d ? 127 - ((s_) - 4) : ((s_) - 4); ci_ = 128 * b + cc_; row0_ = SEQ * b + 64 * cc_; } } while (0)
    if (wave >= 4) {
        const int lt = tid & 127, pair = (wave - 4) >> 1;
        const auto rQ = __builtin_amdgcn_make_buffer_rsrc((void*)(KWS() + WS_QKV), (short)0, (int)((size_t)M_ALL * QKV_LD * 2), 0x00020000);
        const auto rT = __builtin_amdgcn_make_buffer_rsrc((void*)(KWS() + WS_TA), (short)0, (int)((size_t)NCH * 8 * 4 * 4096 * 2), 0x00020000);
        const auto rG = __builtin_amdgcn_make_buffer_rsrc((void*)(KWS() + WS_GC), (short)0, (int)((size_t)NCH * 8 * 2 * GCV * 4), 0x00020000);
        const int vqk = ((d ? 7 - (lt >> 4) : (lt >> 4)) * QKV_LD + 8 * (lt & 15)) * 2, vv_ = ((d ? 15 - (lt >> 3) : (lt >> 3)) * QKV_LD + 8 * (lt & 7)) * 2;
        const int vt = ((lt >> 3) * 64 + 8 * (lt & 7)) * 2, vg0 = lt * 4, vg1 = (128 + lt) * 4, vg2 = (256 + (lt & 3)) * 4;
        u32x4 rq[8], rk[8], rv[4], rt[4], ra[4]; float rc0 = 0.f, rc1 = 0.f, rc2 = 0.f;
        LAS bf16_t* Kw = (LAS bf16_t*)(lds + (1 - pair) * BUFB);
#define BL128(r_, v_, s_) __builtin_bit_cast(u32x4, __builtin_amdgcn_raw_buffer_load_b128(r_, v_, s_, 0))
#define GDN_ISSUE(s_) do { int ci_, row0_; GDN_CHUNK(s_, ci_, row0_); \
            _Pragma("unroll") for (int i_ = 0; i_ < 8; ++i_) { const int so_ = ((row0_ + (d ? 56 - 8 * i_ : 8 * i_)) * QKV_LD + 128 * h) * 2; rq[i_] = BL128(rQ, vqk, so_); rk[i_] = BL128(rQ, vqk, so_ + 2048); } \
            _Pragma("unroll") for (int i_ = 0; i_ < 4; ++i_) { const int so_ = ((row0_ + (d ? 48 - 16 * i_ : 16 * i_)) * QKV_LD + 2048 + 128 * h + 64 * half) * 2; rv[i_] = BL128(rQ, vv_, so_); \
                const int st_ = (((ci_ * 8 + h) * 4 + 2 * d) * 4096 + 16 * i_ * 64) * 2; rt[i_] = BL128(rT, vt, st_); ra[i_] = BL128(rT, vt, st_ + 8192); } \
            { const int sg_ = ((ci_ * 8 + h) * 2 + d) * GCV * 4; rc0 = __builtin_bit_cast(float, __builtin_amdgcn_raw_buffer_load_b32(rG, vg0, sg_, 0)); rc1 = __builtin_bit_cast(float, __builtin_amdgcn_raw_buffer_load_b32(rG, vg1, sg_, 0)); rc2 = __builtin_bit_cast(float, __builtin_amdgcn_raw_buffer_load_b32(rG, vg2, sg_, 0)); } } while (0)
#define GDN_WRITE() do { \
            _Pragma("unroll") for (int i_ = 0; i_ < 8; ++i_) { const int p_ = lt + 128 * i_, pos_ = p_ >> 4, c16_ = p_ & 15; \
                *(LAS u32x4*)(Kw + pos_ * 128 + 8 * (c16_ ^ GSW_K(pos_))) = rk[i_]; *(LAS u32x4*)(Kw + 64 * 128 + pos_ * 128 + 8 * (c16_ ^ GSW_Q(pos_))) = rq[i_]; } \
            _Pragma("unroll") for (int i_ = 0; i_ < 4; ++i_) { const int p_ = lt + 128 * i_, pos_ = p_ >> 3, c8_ = p_ & 7; \
                *(LAS u32x4*)(Kw + 128 * 128 + pos_ * 64 + 8 * (c8_ ^ GSW_V(pos_))) = rv[i_]; *(LAS u32x4*)(Kw + 128 * 128 + 64 * 64 + pos_ * 64 + 8 * (c8_ ^ GSW_T(pos_))) = rt[i_]; \
                *(LAS u32x4*)(Kw + 128 * 128 + 128 * 64 + pos_ * 64 + 8 * (c8_ ^ GSW_A(pos_))) = ra[i_]; } \
            { LAS float* v_ = (LAS float*)(Kw + 128 * 128 + 192 * 64); v_[lt] = rc0; v_[128 + lt] = rc1; if (lt < 4) v_[256 + lt] = rc2; } } while (0)
        if (V & 1) { for (int s = 0; s < 133; ++s) WG_BARRIER(); return; }
        if (pair == 1) { GDN_ISSUE(0); GDN_WRITE(); GDN_ISSUE(2); } else { GDN_ISSUE(1); }
        WG_BARRIER();
        for (int s = 0; s < 132; s += 2) {
            if (pair == 0) { GDN_WRITE(); if (s + 3 < 132) GDN_ISSUE(s + 3); }
            WG_BARRIER();
            if (pair == 1 && s + 2 < 132) { GDN_WRITE(); if (s + 4 < 132) GDN_ISSUE(s + 4); }
            WG_BARRIER();
        }
#undef GDN_ISSUE
#undef GDN_WRITE
#undef BL128
        return;
    }
    bf16_t* O = (V & 8) ? (bf16_t*)(KWS() + 472 * MiB) : (bf16_t*)KOUT() + (size_t)d * M_LAT * 1024;
    const auto rO = __builtin_amdgcn_make_buffer_rsrc((void*)O, (short)0, (int)((size_t)M_LAT * 1024 * 2), 0x00020000);
    if (V & 2) { for (int s = 0; s < 133; ++s) WG_BARRIER(); return; }
    f32x4 S[8];
#pragma unroll
    for (int i = 0; i < 8; ++i) S[i] = (f32x4){0.f, 0.f, 0.f, 0.f};
    WG_BARRIER();
    for (int s = 0; s < 132; ++s) {
        const bool latent = s >= 4; int ci, row0; GDN_CHUNK(s, ci, row0); (void)ci;
        const LAS bf16_t* Kp = (const LAS bf16_t*)(lds + (s & 1) * BUFB); const LAS bf16_t* Qp = Kp + 64 * 128; const LAS bf16_t* Vp = Qp + 64 * 128;
        const LAS bf16_t* Tp = Vp + 64 * 64; const LAS bf16_t* Ap = Tp + 64 * 64; const LAS float* vec = (const LAS float*)(Ap + 64 * 64);
        const int rP = 8 * (n >> 2) + (n & 3);
        const int gkP = ((n & 3) << 2) ^ (((n >> 2) & 1) * 3) ^ ((n >> 3) * 2);
        const int rX = 8 * q + (n >> 2), gkX = ((n >> 2) << 2) ^ ((q & 1) * 3) ^ ((q >> 1) * 2);
#define RD_KF(mi_, ks_) (*(const LAS bf16x8*)(Kp + (rP + 32 * ((mi_) >> 1) + 4 * ((mi_) & 1)) * 128 + 8 * ((4 * (ks_) + q) ^ gkP)))
#define RD_TF(mi_, ks_) (*(const LAS bf16x8*)(Tp + (rP + 32 * ((mi_) >> 1) + 4 * ((mi_) & 1)) * 64 + 8 * ((4 * (ks_) + q) ^ (n >> 1))))
#define RD_QF(ni_, ks_) (*(const LAS bf16x8*)(Qp + (16 * (ni_) + n) * 128 + 8 * ((4 * (ks_) + q) ^ n)))
#define RD_AF(ni_, ks_) (*(const LAS bf16x8*)(Ap + (16 * (ni_) + n) * 64 + 8 * ((4 * (ks_) + q) ^ (n >> 1))))
        bf16x8 Sb[4];
#pragma unroll
        for (int ks = 0; ks < 4; ++ks) Sb[ks] = acc_frag(S[2 * ks], S[2 * ks + 1]);
#define ILV(nm_, nd_) __builtin_amdgcn_sched_group_barrier(0x008, nm_, 0); __builtin_amdgcn_sched_group_barrier(0x100, nd_, 0);
        f32x4 kS[4]; bf16x8 kf[4][4];
#pragma unroll
        for (int ks = 0; ks < 4; ++ks)
#pragma unroll
            for (int mi = 0; mi < 4; ++mi) kf[mi][ks] = RD_KF(mi, ks);
#pragma unroll
        for (int mi = 0; mi < 4; ++mi) kS[mi] = (f32x4){0.f, 0.f, 0.f, 0.f};
        SBAR
#pragma unroll
        for (int ks = 0; ks < 4; ++ks)
#pragma unroll
            for (int mi = 0; mi < 4; ++mi) kS[mi] = mma16(kf[mi][ks], Sb[ks], kS[mi]);
        bf16x8 tf[4][2]; f32x4 eg[4], bt[4], vv[4];
#pragma unroll
        for (int mi = 0; mi < 4; ++mi) { const int p0 = 32 * (mi >> 1) + 8 * q + 4 * (mi & 1);
            eg[mi] = *(const LAS f32x4*)(vec + p0); bt[mi] = *(const LAS f32x4*)(vec + 128 + p0);
            vv[mi] = bf4f(tr4(Vp + (p0 + (n >> 2)) * 64 + 8 * ((2 * (wave & 3) + ((n & 3) >> 1)) ^ ((((n >> 3) & 1) << 1) | ((q & 1) << 2))) + 4 * (n & 1))); }
#pragma unroll
        for (int ks = 0; ks < 2; ++ks)
#pragma unroll
            for (int mi = 0; mi < 4; ++mi) tf[mi][ks] = RD_TF(mi, ks);
        ILV(1, 2) ILV(1, 2) ILV(1, 2) ILV(1, 2) ILV(1, 1) ILV(1, 1) ILV(1, 1) ILV(1, 1) ILV(1, 1) ILV(1, 1) ILV(1, 1) ILV(1, 1) ILV(1, 1) ILV(1, 1) ILV(1, 1) ILV(1, 1)
        SBAR
        f32x4 rr[4];
#pragma unroll
        for (int mi = 0; mi < 4; ++mi) rr[mi] = bt[mi] * (vv[mi] - eg[mi] * kS[mi]);
        const bf16x8 rb[2] = {acc_frag(rr[0], rr[1]), acc_frag(rr[2], rr[3])};
        f32x4 vn[4];
#pragma unroll
        for (int mi = 0; mi < 4; ++mi) vn[mi] = (f32x4){0.f, 0.f, 0.f, 0.f};
#pragma unroll
        for (int ks = 0; ks < 2; ++ks)
#pragma unroll
            for (int mi = 0; mi < 4; ++mi) vn[mi] = mma16(tf[mi][ks], rb[ks], vn[mi]);
        bf16x8 ktr[8][2]; f32x4 ed[4];
#pragma unroll
        for (int mi = 0; mi < 4; ++mi) ed[mi] = *(const LAS f32x4*)(vec + 64 + 32 * (mi >> 1) + 8 * q + 4 * (mi & 1));
        const float egl = vec[256];
#pragma unroll
        for (int ks = 0; ks < 2; ++ks)
#pragma unroll
            for (int mt = 0; mt < 8; ++mt) { const LAS bf16_t* p = Kp + (32 * ks + rX) * 128 + 8 * ((4 * (mt >> 1) + (n & 3)) ^ gkX) + 4 * (mt & 1);
                const bf16x4 a = tr4(p), b = tr4(p + 4 * 128); ktr[mt][ks] = (bf16x8){a[0], a[1], a[2], a[3], b[0], b[1], b[2], b[3]}; }
        ILV(1, 5) ILV(1, 5) ILV(1, 5) ILV(1, 5) ILV(1, 5) ILV(1, 5) ILV(1, 5) ILV(1, 5)
        SBAR
        f32x4 vp[4];
#pragma unroll
        for (int mi = 0; mi < 4; ++mi) vp[mi] = vn[mi] * ed[mi];
        const bf16x8 vpb[2] = {acc_frag(vp[0], vp[1]), acc_frag(vp[2], vp[3])};
#pragma unroll
        for (int mt = 0; mt < 8; ++mt) {
#pragma unroll
            for (int e = 0; e < 4; ++e) { float t = S[mt][e] * egl; asm volatile("" : "+v"(t)); S[mt][e] = t; } }
#pragma unroll
        for (int ks = 0; ks < 2; ++ks)
#pragma unroll
            for (int mt = 0; mt < 8; ++mt) S[mt] = mma16(ktr[mt][ks], vpb[ks], S[mt]);
        f32x4 qT[4], oT[4]; float ev[4]; bf16x8 qf[4][4];
#pragma unroll
        for (int ks = 0; ks < 4; ++ks)
#pragma unroll
            for (int ni = 0; ni < 4; ++ni) qf[ni][ks] = RD_QF(ni, ks);
#pragma unroll
        for (int ni = 0; ni < 4; ++ni) ev[ni] = vec[192 + 16 * ni + n];
        ILV(1, 2) ILV(1, 2) ILV(1, 2) ILV(1, 2) ILV(1, 1) ILV(1, 1) ILV(1, 1) ILV(1, 1) ILV(1, 1) ILV(1, 1) ILV(1, 1) ILV(1, 1) ILV(1, 1) ILV(1, 1) ILV(1, 1) ILV(1, 1)
        SBAR
#pragma unroll
        for (int ni = 0; ni < 4; ++ni) { qT[ni] = (f32x4){0.f, 0.f, 0.f, 0.f}; oT[ni] = (f32x4){0.f, 0.f, 0.f, 0.f}; }
#pragma unroll
        for (int ks = 0; ks < 4; ++ks)
#pragma unroll
            for (int ni = 0; ni < 4; ++ni) qT[ni] = mma16(Sb[ks], qf[ni][ks], qT[ni]);
        const bf16x8 vb[2] = {acc_frag(vn[0], vn[1]), acc_frag(vn[2], vn[3])};
        bf16x8 af[4][2];
#pragma unroll
        for (int ks = 0; ks < 2; ++ks)
#pragma unroll
            for (int ni = 0; ni < 4; ++ni) af[ni][ks] = RD_AF(ni, ks);
        ILV(2, 1) ILV(2, 1) ILV(2, 1) ILV(2, 1) ILV(2, 1) ILV(2, 1) ILV(2, 1) ILV(2, 1)
        SBAR
#pragma unroll
        for (int ks = 0; ks < 2; ++ks)
#pragma unroll
            for (int ni = 0; ni < 4; ++ni) oT[ni] = mma16(vb[ks], af[ni][ks], oT[ni]);
        SBAR
        if (latent) {
#pragma unroll
            for (int p = 0; p < 2; ++p) {
                const f32x4 A = oT[2 * p] + qT[2 * p] * ev[2 * p], B = oT[2 * p + 1] + qT[2 * p + 1] * ev[2 * p + 1]; float o[8];
#pragma unroll
                for (int e = 0; e < 4; ++e) { const float ae = A[e], be = B[e];
                    const auto r = __builtin_amdgcn_permlane16_swap(__float_as_uint(ae), __float_as_uint(be), false, false);
                    o[e] = __uint_as_float(r[0]); o[4 + e] = __uint_as_float(r[1]); }
                const int pos = 16 * (2 * p + (q & 1)) + n;
                if (V & 8) { const size_t orow = (size_t)row0 + (d ? 63 - pos : pos); *(u32x4*)(O + ((orow * 1024 + 128 * h + dv0 + 8 * (q >> 1)) & 0xffffff)) = pack8(o); }
                else __builtin_amdgcn_raw_buffer_store_b128(__builtin_bit_cast(decltype(__builtin_amdgcn_raw_buffer_load_b128(rO, 0, 0, 0)), pack8(o)), rO, ((d ? 63 - pos : pos) * 1024 + 128 * h + dv0 + 8 * (q >> 1)) * 2, row0 * 2048, 0); }
        }
#undef ILV
        SBAR
        WG_BARRIER();
    }
#undef GDN_CHUNK
#undef RD_KF
#undef RD_TF
#undef RD_QF
#undef RD_AF
}

constexpr int XP8 = 520;
__device__ __forceinline__ void ssd_diag_phase(LAS unsigned char* lds) {
    const int tid = threadIdx.x, lane = tid & 63, wave = tid >> 6, n = lane & 15, q = lane >> 4;
    const bf16_t* XBC = (const bf16_t*)(KWS() + WS_XBC); const float* SM = (const float*)(KWS() + WS_SMALL); bf16_t* Y = (bf16_t*)(KWS() + WS_Y);
    LAS bf16_t* Cp = (LAS bf16_t*)lds;
    LAS bf16_t* Bp = Cp + 64 * KP;
    LAS bf16_t* Xp = Bp + 64 * KP;
    LAS float* CBs = (LAS float*)(Xp + 64 * XP8);
    LAS float* vecs = CBs + 64 * 68;
    u32x4 pb[2], pc[2], px[8]; float pdf = 0.f, pdb = 0.f;
#define DIAG_ISSUE(unit_) do { const int ci_ = (unit_) >> 2, grp_ = (unit_) & 3, row0_ = ci_ * 64, hh_ = 8 * grp_ + wave; \
        _Pragma("unroll") for (int i_ = 0; i_ < 2; ++i_) { const int pc_ = tid + 512 * i_, pos_ = pc_ >> 4, c16_ = pc_ & 15; const bf16_t* g_ = XBC + (size_t)(row0_ + pos_) * XBC_LD + 2048 + 128 * grp_ + 8 * c16_; pb[i_] = *(const u32x4*)g_; pc[i_] = *(const u32x4*)(g_ + 512); } \
        _Pragma("unroll") for (int i_ = 0; i_ < 8; ++i_) { const int pc_ = tid + 512 * i_, pos_ = pc_ >> 6, c64_ = pc_ & 63; px[i_] = *(const u32x4*)(XBC + (size_t)(row0_ + pos_) * XBC_LD + 512 * grp_ + 8 * c64_); } \
        pdf = SM[(size_t)(row0_ + lane) * SMALL_LD + 32 + hh_]; pdb = SM[(size_t)(row0_ + lane) * SMALL_LD + 64 + hh_]; } while (0)
    int unit = blockIdx.x;
    if (unit < NCH_LAT * 4) DIAG_ISSUE(unit);
    for (; unit < NCH_LAT * 4; unit += gridDim.x) {
        const int ci = unit >> 2, grp = unit & 3, row0 = ci * 64, hh = 8 * grp + wave;
        __syncthreads();
#pragma unroll
        for (int i = 0; i < 2; ++i) { const int pc_ = tid + 512 * i, pos = pc_ >> 4, c16 = pc_ & 15; *(LAS u32x4*)(Bp + pos * KP + 8 * c16) = pb[i]; *(LAS u32x4*)(Cp + pos * KP + 8 * c16) = pc[i]; }
#pragma unroll
        for (int i = 0; i < 8; ++i) { const int pc_ = tid + 512 * i, pos = pc_ >> 6, c64 = pc_ & 63; *(LAS u32x4*)(Xp + pos * XP8 + 8 * c64) = px[i]; }
        {
            const float a_f = -expf(KIN(I_SALOG)[hh]), a_b = -expf(KIN(I_SALOG)[32 + hh]);
            const float dtf = pdf, dtb = pdb;
            float af = dtf * a_f, ab = dtb * a_b;
#pragma unroll
            for (int o = 1; o < 64; o <<= 1) { const float t = __shfl_up(af, o); if (lane >= o) af += t; const float u = __shfl_down(ab, o); if (lane + o < 64) ab += u; }
            LAS float* v = vecs + wave * 256; v[lane] = af; v[64 + lane] = ab; v[128 + lane] = dtf; v[192 + lane] = dtb; }
        if (unit + (int)gridDim.x < NCH_LAT * 4) DIAG_ISSUE(unit + gridDim.x);
        __syncthreads();
        for (int t = wave * 2; t < wave * 2 + 2; ++t) { const int mi = t >> 2, ni = t & 3; f32x4 c = (f32x4){0.f, 0.f, 0.f, 0.f};
#pragma unroll
            for (int ks = 0; ks < 4; ++ks) c = mma16(frag_std(Cp, KP, 16 * mi, 32 * ks, lane), frag_std(Bp, KP, 16 * ni, 32 * ks, lane), c);
#pragma unroll
            for (int r = 0; r < 4; ++r) CBs[(16 * mi + 4 * q + r) * 68 + 16 * ni + n] = c[r]; }
        __syncthreads();
        const LAS float* v = vecs + wave * 256; const float Dh = KIN(I_SD)[hh];
        bf16x8 xa[4][2];
#pragma unroll
        for (int pt = 0; pt < 4; ++pt)
#pragma unroll
            for (int ks = 0; ks < 2; ++ks) xa[pt][ks] = frag_tr_std(Xp, XP8, 32 * ks, 64 * wave + 16 * pt, lane);
#pragma unroll
        for (int mi = 0; mi < 4; ++mi) {
            const int i = 16 * mi + n; const float af_i = v[i], ab_i = v[64 + i], dd_i = v[128 + i] + v[192 + i];
            f32x4 yT[4];
#pragma unroll
            for (int pt = 0; pt < 4; ++pt) yT[pt] = (f32x4){0.f, 0.f, 0.f, 0.f};
#pragma unroll
            for (int ks = 0; ks < 2; ++ks) { const int j0 = 32 * ks + 8 * q; float m[8];
#pragma unroll
                for (int hf = 0; hf < 2; ++hf) { const f32x4 cb = *(const LAS f32x4*)(CBs + i * 68 + j0 + 4 * hf), afj = *(const LAS f32x4*)(v + j0 + 4 * hf), abj = *(const LAS f32x4*)(v + 64 + j0 + 4 * hf),
                        dfj = *(const LAS f32x4*)(v + 128 + j0 + 4 * hf), dbj = *(const LAS f32x4*)(v + 192 + j0 + 4 * hf);
#pragma unroll
                    for (int e = 0; e < 4; ++e) { const int j = j0 + 4 * hf + e; const bool lo = j < i;
                        const float arg = lo ? (af_i - afj[e]) : (ab_i - abj[e]); const float w = lo ? dfj[e] : dbj[e];
                        m[4 * hf + e] = cb[e] * ((j == i) ? dd_i : __expf(arg) * w); } }
                const bf16x8 Mb = __builtin_bit_cast(bf16x8, pack8(m));
#pragma unroll
                for (int pt = 0; pt < 4; ++pt) yT[pt] = mma16(xa[pt][ks], Mb, yT[pt]); }
#pragma unroll
            for (int p = 0; p < 2; ++p) {
                const f32x4 A = yT[2 * p] + unpack4(*(const LAS u32x2*)(Xp + i * XP8 + 64 * wave + 16 * (2 * p) + 4 * q)) * Dh, B = yT[2 * p + 1] + unpack4(*(const LAS u32x2*)(Xp + i * XP8 + 64 * wave + 16 * (2 * p + 1) + 4 * q)) * Dh; float o[8];
#pragma unroll
                for (int e = 0; e < 4; ++e) { const float ae = A[e], be = B[e];
                    const auto r = __builtin_amdgcn_permlane16_swap(__float_as_uint(ae), __float_as_uint(be), false, false);
                    o[e] = __uint_as_float(r[0]); o[4 + e] = __uint_as_float(r[1]); }
                *(u32x4*)(Y + (size_t)(row0 + i) * 2048 + 64 * hh + 16 * (2 * p + (q & 1)) + 8 * (q >> 1)) = pack8(o); }
        }
    }
#undef DIAG_ISSUE
}

constexpr int XH = 40;
template <int V> __device__ __forceinline__ void ssd_scan_phase(LAS unsigned char* lds) {
    if (blockIdx.x >= NB * 32 * 2) return;
    const int tid = threadIdx.x, lane = tid & 63, wave = __builtin_amdgcn_readfirstlane(tid >> 6), n = lane & 15, q = lane >> 4;
    const int pr = (blockIdx.x & 7) * 2 + ((blockIdx.x >> 3) >> 4), wi = (blockIdx.x >> 3) & 15;
    const int b = pr >> 2, grp = pr & 3, hh = 8 * grp + (wi >> 1), ph = wi & 1;
    constexpr int DIRB = (2 * 64 * 128 + 64 * XH) * 2 + 512, BUFB = 2 * DIRB;
#define SSD_ROW0(s_, dd_) (((s_) < 4) ? (M_LAT + CTXL * b + 64 * ((dd_) ? 3 - (s_) : (s_))) : (SEQ * b + 64 * ((dd_) ? 127 - ((s_) - 4) : ((s_) - 4))))
    if (wave >= 4) {
        const int pair = (wave - 4) >> 1, sdd = (wave - 4) & 1;
        const auto rX = __builtin_amdgcn_make_buffer_rsrc((void*)(KWS() + WS_XBC), (short)0, (int)((size_t)M_ALL * XBC_LD * 2), 0x00020000);
        const auto rS = __builtin_amdgcn_make_buffer_rsrc((void*)(KWS() + WS_SMALL), (short)0, (int)((size_t)M_ALL * SMALL_LD * 4), 0x00020000);
        const float a_sd = -expf(KIN(I_SALOG)[sdd * 32 + hh]);
        const int vcb = ((sdd ? 3 - (lane >> 4) : (lane >> 4)) * XBC_LD + 8 * (lane & 15)) * 2, vx = ((sdd ? 15 - (lane >> 2) : (lane >> 2)) * XBC_LD + 8 * (lane & 3)) * 2, vd = (sdd ? 63 - lane : lane) * SMALL_LD * 4;
        u32x4 rc[16], rb[16], rx[4]; float rdt = 0.f;
        LAS bf16_t* Cs = (LAS bf16_t*)(lds + (1 - pair) * BUFB + sdd * DIRB);
#define BL128(r_, v_, s_) __builtin_bit_cast(u32x4, __builtin_amdgcn_raw_buffer_load_b128(r_, v_, s_, 0))
#define SSD_ISSUE_CB(s_) do { const int row0_ = SSD_ROW0(s_, sdd); \
            _Pragma("unroll") for (int i_ = 0; i_ < 16; ++i_) { const int so_ = ((row0_ + (sdd ? 60 - 4 * i_ : 4 * i_)) * XBC_LD + 2048 + 128 * grp) * 2; rb[i_] = BL128(rX, vcb, so_); rc[i_] = BL128(rX, vcb, so_ + 1024); } } while (0)
#define SSD_ISSUE_X(s_) do { const int row0_ = SSD_ROW0(s_, sdd); \
            _Pragma("unroll") for (int i_ = 0; i_ < 4; ++i_) { const int so_ = ((row0_ + (sdd ? 48 - 16 * i_ : 16 * i_)) * XBC_LD + 64 * hh + 32 * ph) * 2; rx[i_] = BL128(rX, vx, so_); } \
            rdt = __builtin_bit_cast(float, __builtin_amdgcn_raw_buffer_load_b32(rS, vd, (row0_ * SMALL_LD + 32 + 32 * sdd + hh) * 4, 0)); } while (0)
#define SSD_WRITE_CB() do { \
            _Pragma("unroll") for (int i_ = 0; i_ < 16; ++i_) { const int pc_ = lane + 64 * i_, pos_ = pc_ >> 4, c16_ = pc_ & 15; *(LAS u32x4*)(Cs + pos_ * 128 + 8 * (c16_ ^ (pos_ & 15))) = rc[i_]; *(LAS u32x4*)(Cs + 64 * 128 + pos_ * 128 + 8 * (c16_ ^ ((pos_ & 3) << 2))) = rb[i_]; } } while (0)
#define SSD_WRITE_X() do { \
            { LAS float* eas_ = (LAS float*)(Cs + 128 * 128 + 64 * XH); float ac_ = rdt * a_sd; \
                  \
                ac_ += DPP0(ac_, 0x111); ac_ += DPP0(ac_, 0x112); ac_ += DPP0(ac_, 0x114); ac_ += DPP0(ac_, 0x118); \
                { const float t0_ = __shfl(ac_, 15), t1_ = __shfl(ac_, 31), t2_ = __shfl(ac_, 47); ac_ += (lane >= 16 ? t0_ : 0.f) + (lane >= 32 ? t1_ : 0.f) + (lane >= 48 ? t2_ : 0.f); } \
                const float al_ = __shfl(ac_, 63); const float wl_ = __expf(al_ - ac_) * rdt; eas_[lane] = __expf(ac_); \
                  \
                _Pragma("unroll") for (int i_ = 0; i_ < 4; ++i_) { const int pc_ = lane + 64 * i_; const float w_ = __shfl(wl_, pc_ >> 2); float f_[8]; unpack8(rx[i_], f_); \
                    _Pragma("unroll") for (int e_ = 0; e_ < 8; ++e_) f_[e_] *= w_; \
                    *(LAS u32x4*)(Cs + 128 * 128 + (pc_ >> 2) * XH + 8 * (pc_ & 3)) = pack8(f_); } } } while (0)
#define DPP0(v_, ctrl_) __builtin_bit_cast(float, __builtin_amdgcn_update_dpp(0, __builtin_bit_cast(int, v_), ctrl_, 0xf, 0xf, false))
        if (V & 1) { for (int s = 0; s < 133; ++s) WG_BARRIER(); return; }
        if (pair == 1) { SSD_ISSUE_CB(0); SSD_ISSUE_X(0); SSD_WRITE_CB(); SSD_WRITE_X(); SSD_ISSUE_CB(2); SSD_ISSUE_X(2); } else { SSD_ISSUE_CB(1); SSD_ISSUE_X(1); }
        WG_BARRIER();
        for (int s = 0; s < 132; s += 2) {
            if (pair == 0) { SSD_WRITE_CB(); SSD_WRITE_X(); if (s + 3 < 132) { SSD_ISSUE_CB(s + 3); SSD_ISSUE_X(s + 3); } }
            WG_BARRIER();
            if (pair == 1 && s + 2 < 132) { SSD_WRITE_CB(); SSD_WRITE_X(); if (s + 4 < 132) { SSD_ISSUE_CB(s + 4); SSD_ISSUE_X(s + 4); } }
            WG_BARRIER();
        }
#undef DPP0
#undef SSD_ISSUE_CB
#undef SSD_ISSUE_X
#undef SSD_WRITE_CB
#undef SSD_WRITE_X
#undef BL128
        return;
    }
    const int d = (wave >> 1) & 1, pl = 16 * (wave & 1), pcol = 64 * hh + 32 * ph + pl;
    bf16_t* Y = (V & 8) ? (bf16_t*)(KWS() + WS_TA) : (bf16_t*)(KWS() + WS_Y);
    const auto rY = __builtin_amdgcn_make_buffer_rsrc((void*)Y, (short)0, (int)((size_t)M_LAT * 2048 * 2), 0x00020000);
    if (V & 2) { for (int s = 0; s < 133; ++s) WG_BARRIER(); return; }
    f32x4 hs[8];
#pragma unroll
    for (int i = 0; i < 8; ++i) hs[i] = (f32x4){0.f, 0.f, 0.f, 0.f};
    WG_BARRIER();
    for (int s = 0; s < 132; ++s) {
        const bool latent = s >= 4; const int row0 = SSD_ROW0(s, d);
        u32x4 yl[2] = {};
#define SSD_YVOFF(p_) ((((d ? 63 - (16 * (2 * (p_) + (q & 1)) + n) : (16 * (2 * (p_) + (q & 1)) + n))) * 2048 + pcol + 8 * (q >> 1)) * 2)
        if (latent && !(V & 4) && !(V & 16)) {
#pragma unroll
            for (int p = 0; p < 2; ++p) yl[p] = __builtin_bit_cast(u32x4, __builtin_amdgcn_raw_buffer_load_b128(rY, SSD_YVOFF(p), row0 * 4096, 0));
        }
        const LAS bf16_t* Cp = (const LAS bf16_t*)(lds + (s & 1) * BUFB + d * DIRB); const LAS bf16_t* Bp = Cp + 64 * 128; const LAS bf16_t* Xp = Bp + 64 * 128;
        const LAS float* ea = (const LAS float*)(Xp + 64 * XH);
        bf16x8 hb[4];
#pragma unroll
        for (int ks = 0; ks < 4; ++ks) hb[ks] = acc_frag(hs[2 * ks], hs[2 * ks + 1]);
        bf16x8 btr[8][2]; bf16x8 xb[2];
#pragma unroll
        for (int ks = 0; ks < 2; ++ks)
#pragma unroll
          for (int mt = 0; mt < 8; ++mt) { const LAS bf16_t* p = Bp + (32 * ks + 8 * q + (n >> 2)) * 128 + 8 * (4 * ((mt >> 1) ^ (n >> 2)) + (n & 3)) + 4 * (mt & 1);
              const bf16x4 a = tr4(p), b = tr4(p + 4 * 128); btr[mt][ks] = (bf16x8){a[0], a[1], a[2], a[3], b[0], b[1], b[2], b[3]}; }
#pragma unroll
        for (int ks = 0; ks < 2; ++ks) { const LAS bf16_t* p = Xp + (32 * ks + 8 * q + (n >> 2)) * XH + pl + 4 * (n & 3);
            const bf16x4 x0 = tr4(p), x1 = tr4(p + 4 * XH); xb[ks] = (bf16x8){x0[0], x0[1], x0[2], x0[3], x1[0], x1[1], x1[2], x1[3]}; }
        const float eal = ea[63];
        SBAR
#pragma unroll
        for (int mt = 0; mt < 8; ++mt) {
#pragma unroll
            for (int e = 0; e < 4; ++e) { float t = hs[mt][e] * eal; asm volatile("" : "+v"(t)); hs[mt][e] = t; } }
#pragma unroll
        for (int ks = 0; ks < 2; ++ks)
#pragma unroll
            for (int mt = 0; mt < 8; ++mt) hs[mt] = mma16(btr[mt][ks], xb[ks], hs[mt]);
        bf16x8 cf[4][4]; f32x4 yT[4]; float eai[4];
#pragma unroll
        for (int ks = 0; ks < 4; ++ks)
#pragma unroll
            for (int ni = 0; ni < 4; ++ni) cf[ni][ks] = *(const LAS bf16x8*)(Cp + (16 * ni + n) * 128 + 8 * ((4 * ks + q) ^ n));
#pragma unroll
        for (int ni = 0; ni < 4; ++ni) eai[ni] = ea[16 * ni + n];
#define ILV(nm_, nd_) __builtin_amdgcn_sched_group_barrier(0x008, nm_, 0); __builtin_amdgcn_sched_group_barrier(0x100, nd_, 0);
        ILV(1, 2) ILV(1, 2) ILV(1, 2) ILV(1, 2) ILV(1, 1) ILV(1, 1) ILV(1, 1) ILV(1, 1) ILV(1, 1) ILV(1, 1) ILV(1, 1) ILV(1, 1) ILV(1, 1) ILV(1, 1) ILV(1, 1) ILV(1, 1)
#undef ILV
        SBAR
#pragma unroll
        for (int ni = 0; ni < 4; ++ni) yT[ni] = (f32x4){0.f, 0.f, 0.f, 0.f};
#pragma unroll
        for (int ks = 0; ks < 4; ++ks)
#pragma unroll
            for (int ni = 0; ni < 4; ++ni) yT[ni] = mma16(hb[ks], cf[ni][ks], yT[ni]);
        SBAR
        if (latent && !(V & 4)) {
            asm volatile("s_waitcnt vmcnt(0)" ::: "memory");
#pragma unroll
            for (int p = 0; p < 2; ++p) { const f32x4 A = yT[2 * p] * eai[2 * p], B = yT[2 * p + 1] * eai[2 * p + 1];
                float o[8]; unpack8(yl[p], o);
#pragma unroll
                for (int e = 0; e < 4; ++e) {
                    const float ae = A[e], be = B[e];
                    const auto r = __builtin_amdgcn_permlane16_swap(__float_as_uint(ae), __float_as_uint(be), false, false);
                    o[e] += __uint_as_float(r[0]); o[4 + e] += __uint_as_float(r[1]); }
                if (!(V & 16)) __builtin_amdgcn_raw_buffer_store_b128(__builtin_bit_cast(decltype(__builtin_amdgcn_raw_buffer_load_b128(rY, 0, 0, 0)), pack8(o)), rY, SSD_YVOFF(p), row0 * 4096, 0); else asm volatile("" :: "v"(o[0]), "v"(o[7])); }
            if (s == 67) asm volatile("s_waitcnt vmcnt(0)" ::: "memory");
        }
        SBAR
        WG_BARRIER();
    }
#undef SSD_YVOFF
#undef SSD_ROW0
}
#undef SBAR

__device__ __forceinline__ void ostat_phase(int first_block) {
    if ((int)blockIdx.x < first_block) return;
    const int lane = threadIdx.x & 63, wave = threadIdx.x >> 6; const int gw = ((int)blockIdx.x - first_block) * 8 + wave, NGW = ((int)gridDim.x - first_block) * 8;
    const bf16_t* of = (const bf16_t*)KOUT(); const bf16_t* ob = of + (size_t)M_LAT * 1024; float* ost = (float*)(KWS() + WS_OST);
    for (int bt = gw; bt < M_LAT / 4; bt += NGW) { const int per = 0, i0 = 4 * bt; (void)per;
        u32x4 x0[4], x1[4], y0[4], y1[4];
#pragma unroll
        for (int r = 0; r < 4; ++r) { const size_t o = (size_t)(i0 + r) * 1024 + 16 * lane; x0[r] = *(const u32x4*)(of + o); x1[r] = *(const u32x4*)(of + o + 8); y0[r] = *(const u32x4*)(ob + o); y1[r] = *(const u32x4*)(ob + o + 8); }
#pragma unroll
        for (int r = 0; r < 4; ++r) { float a0[8], a1[8], b0[8], b1[8]; unpack8(x0[r], a0); unpack8(x1[r], a1); unpack8(y0[r], b0); unpack8(y1[r], b1);
            float s = 0.f;
#pragma unroll
            for (int e = 0; e < 8; ++e) { const float u = a0[e] + b0[e], v = a1[e] + b1[e]; s += u * u + v * v; }
            s += __shfl_xor(s, 1); s += __shfl_xor(s, 2); s += __shfl_xor(s, 4);
            if ((lane & 7) == 0) ost[(size_t)(i0 + r) * 8 + (lane >> 3)] = rsqrtf(s * (1.f / 128.f) + EPS); }
    }
}
__device__ __forceinline__ void ynorm_phase(const Args& a) {
    const int lane = threadIdx.x & 63, wave = threadIdx.x >> 6; const int gw = blockIdx.x * 8 + wave, NGW = gridDim.x * 8;
    const float* ps = (const float*)(KWS() + WS_PS); float* rat = (float*)(KWS() + WS_RAT);
    for (int row = gw; row < M_LAT; row += NGW) {
        float s = ps[(size_t)row * 64 + lane];
        s += __shfl_xor(s, 1); s += __shfl_xor(s, 2); s += __shfl_xor(s, 4); s += __shfl_xor(s, 8);
        const float r = rsqrtf(s * (1.f / 512.f) + EPS), rn = __shfl(r, (lane + 16) & 63);
        if ((lane & 15) == 0) rat[(size_t)row * 4 + (lane >> 4)] = (lane < 48) ? r / rn : r;
    }
}
__device__ __forceinline__ void fnorm_phase(const Args& a) {
    const int lane = threadIdx.x & 63, wave = threadIdx.x >> 6; const int gw = blockIdx.x * 8 + wave, NGW = gridDim.x * 8;
    const bf16_t* P = (const bf16_t*)(KWS() + WS_P); bf16_t* h1 = (bf16_t*)(KWS() + WS_H1); const float* mod = (const float*)(KWS() + WS_MOD); bf16_t* F = (bf16_t*)(KWS() + WS_F); const float* X = KIN(I_X);
    const int per = M_LAT / NGW;
    const int b = (gw * per) / SEQ;
    f32x4 sc[4], sh[4];
#pragma unroll
    for (int j = 0; j < 4; ++j) { const int c = 4 * lane + 256 * j; const f32x4 w = *(const f32x4*)(KIN(I_N2W) + c), s2 = *(const f32x4*)(mod + b * 6144 + 4096 + c);
        sc[j] = w * (s2 + 1.0f); sh[j] = *(const f32x4*)(mod + b * 6144 + 3072 + c); }
    for (int i0 = 0; i0 < per; i0 += 4) {
        f32x4 v[4][4]; u32x2 pw[4][4];
#pragma unroll
        for (int r = 0; r < 4; ++r) { const size_t row = gw * per + i0 + r;
#pragma unroll
            for (int j = 0; j < 4; ++j) { v[r][j] = *(const f32x4*)(X + row * 1024 + 4 * lane + 256 * j); pw[r][j] = *(const u32x2*)(P + row * 1024 + 4 * lane + 256 * j); } }
#pragma unroll
        for (int r = 0; r < 4; ++r) { const size_t row = gw * per + i0 + r; float ss = 0.f;
#pragma unroll
            for (int j = 0; j < 4; ++j) { v[r][j] = v[r][j] + (f32x4){bflo(pw[r][j].x), bfhi(pw[r][j].x), bflo(pw[r][j].y), bfhi(pw[r][j].y)};
                ss += (v[r][j][0] * v[r][j][0] + v[r][j][1] * v[r][j][1]) + (v[r][j][2] * v[r][j][2] + v[r][j][3] * v[r][j][3]); }
            const float rs = rsqrtf(wave_sum(ss) * (1.f / 1024.f) + EPS);
#pragma unroll
            for (int j = 0; j < 4; ++j) { const f32x4 o = v[r][j] * rs * sc[j] + sh[j];
                u32x2 w; w.x = cvt_pk_bf16(o[0], o[1]); w.y = cvt_pk_bf16(o[2], o[3]); *(u32x2*)(F + row * 1024 + 4 * lane + 256 * j) = w;
                u32x2 hw; hw.x = cvt_pk_bf16(v[r][j][0], v[r][j][1]); hw.y = cvt_pk_bf16(v[r][j][2], v[r][j][3]); *(u32x2*)(h1 + row * 1024 + 4 * lane + 256 * j) = hw; } }
    }
}
__device__ __forceinline__ void final_phase(const Args& a) {
    const int lane = threadIdx.x & 63, wave = threadIdx.x >> 6; const int gw = blockIdx.x * 8 + wave, NGW = gridDim.x * 8, per = M_LAT / NGW;
    float* out = KOUT(); const bf16_t* h1 = (const bf16_t*)(KWS() + WS_H1); const bf16_t* P = (const bf16_t*)(KWS() + WS_P);
    f32x4 wv[4];
#pragma unroll
    for (int j = 0; j < 4; ++j) wv[j] = *(const f32x4*)(KIN(I_NFW) + 4 * lane + 256 * j);
    for (int i0 = 0; i0 < per; i0 += 4) {
        u32x2 hw[4][4], pw[4][4];
#pragma unroll
        for (int r = 0; r < 4; ++r) { const size_t row = gw * per + i0 + r;
#pragma unroll
            for (int j = 0; j < 4; ++j) { hw[r][j] = *(const u32x2*)(h1 + row * 1024 + 4 * lane + 256 * j); pw[r][j] = *(const u32x2*)(P + row * 1024 + 4 * lane + 256 * j); } }
#pragma unroll
        for (int r = 0; r < 4; ++r) { const size_t row = gw * per + i0 + r; float ss = 0.f; f32x4 v[4];
#pragma unroll
            for (int j = 0; j < 4; ++j) { v[j] = (f32x4){bflo(hw[r][j].x), bfhi(hw[r][j].x), bflo(hw[r][j].y), bfhi(hw[r][j].y)} + (f32x4){bflo(pw[r][j].x), bfhi(pw[r][j].x), bflo(pw[r][j].y), bfhi(pw[r][j].y)};
                ss += (v[j][0] * v[j][0] + v[j][1] * v[j][1]) + (v[j][2] * v[j][2] + v[j][3] * v[j][3]); }
            const float rs = rsqrtf(wave_sum(ss) * (1.f / 1024.f) + EPS);
#pragma unroll
            for (int j = 0; j < 4; ++j) *(f32x4*)(out + row * 1024 + 4 * lane + 256 * j) = v[j] * rs * wv[j]; }
    }
}

__global__ void __launch_bounds__(512, 2) fwd_kernel(Args a) {
    extern __shared__ __attribute__((aligned(16))) unsigned char lds_raw[];
    LAS unsigned char* lds = (LAS unsigned char*)lds_raw;
    cg::grid_group grid = cg::this_grid();
    const int lo = a.ph_lo, hi = a.ph_hi, G = gridDim.x, bx = blockIdx.x;
    unsigned char* ws = KWS(); (void)ws;
    volatile LAS unsigned* bst = (volatile LAS unsigned*)(lds + LDS_BYTES - 64);
    if (threadIdx.x < 2) bst[threadIdx.x] = 0u;
    __syncthreads();
    XcdBarrier xbar = xcd_barrier_post((unsigned*)(ws + WS_CTL), bst);
    if (lo > 1000) grid.sync();
#define IN(k) (lo <= (k) && (k) < hi)
#define SEAM(k) do { if (IN(k) && IN((k) + 1)) { xcd_barrier(xbar); } } while (0)
    using namespace pg8;
    if (IN(0)) p0_prologue(a, lds);
    SEAM(0);
    if (IN(1)) p1_norm_mod(a);
    SEAM(1);
    if (IN(2)) {
        Gemm g{(const bf16_t*)(ws + WS_A), (const bf16_t*)(ws + WS_W1A), M_ALL, N1A, 1024}; StaticOrder S; S.init(M_ALL, N1A, G, bx);
        EpiConv E{(bf16_t*)(ws + WS_QKV), QKV_LD, KIN(I_GCW), KIN(I_GCB), 12, (float*)(ws + WS_SMALL), (const float*)(ws + WS_PAR), (LAS float*)(lds + XL_OFF)};
        gemm_phase<EpiConv, StaticOrder, true, true>(lds, g, S, E); }
    SEAM(2);
    if (IN(3)) gdn_prep_phase<0>(lds);
    SEAM(3);
    if (IN(4)) gdn_scan_phase<0>(lds);
    SEAM(4);
    if (IN(5)) {
        Gemm g{(const bf16_t*)(ws + WS_A), (const bf16_t*)(ws + WS_W1B), M_ALL, N1B, 1024}; StaticOrder S; S.init(M_ALL, N1B, G, bx);
        EpiConv E{(bf16_t*)(ws + WS_XBC), XBC_LD, KIN(I_SCW), KIN(I_SCB), 12, nullptr, nullptr, (LAS float*)(lds + XL_OFF)};
        gemm_phase<EpiConv, StaticOrder, true, true>(lds, g, S, E);
        ostat_phase((M_ALL / 256) * (N1B / 256) - 6 * 256); }
    SEAM(5);
    if (IN(6)) ssd_diag_phase(lds);
    SEAM(6);
    if (IN(7)) ssd_scan_phase<0>(lds);
    SEAM(7);
    if (IN(8)) ;
    if (IN(9)) {
        Gemm g{(const bf16_t*)(ws + WS_A), (const bf16_t*)(ws + WS_WZ), M_LAT, NZ, 1024}; StaticOrder S; S.init(M_LAT, NZ, G, bx);
        EpiZ E{(bf16_t*)KOUT(), (const bf16_t*)KOUT() + (size_t)M_LAT * 1024, (const float*)(ws + WS_OST), KIN(I_GNW), (bf16_t*)(ws + WS_Y), (float*)(ws + WS_PS), (bf16_t*)(ws + WS_GATES)};
        gemm_phase<EpiZ, StaticOrder, true, true>(lds, g, S, E); }
    SEAM(9);
    if (IN(10)) ynorm_phase(a);
    if (IN(11)) {
        Gemm g{(const bf16_t*)KOUT(), (const bf16_t*)(ws + WS_WBG), M_LAT, 1024, 1024}; StaticOrder S; S.init(M_LAT, 1024, G, bx);
        EpiBR<0> E{(const bf16_t*)(ws + WS_GATES), (bf16_t*)(ws + WS_M1), nullptr, nullptr};
        gemm_phase<EpiBR<0>, StaticOrder, true, true>(lds, g, S, E); }
    SEAM(11);
    if (IN(12)) {
        Gemm g{(const bf16_t*)(ws + WS_Y), (const bf16_t*)(ws + WS_WBS), M_LAT, 1024, 2048}; StaticOrder S; S.init(M_LAT, 1024, G, bx);
        EpiBR<1> E{(const bf16_t*)(ws + WS_GATES), (bf16_t*)(ws + WS_M1), (bf16_t*)(ws + WS_A), (const float*)(ws + WS_RAT)};
        gemm_phase<EpiBR<1>, StaticOrder, true, true>(lds, g, S, E); }
    SEAM(12);
    if (IN(13)) {
        Gemm g{(const bf16_t*)(ws + WS_A), (const bf16_t*)(ws + WS_WO), M_LAT, 1024, 1024}; StaticOrder S; S.init(M_LAT, 1024, G, bx);
        EpiP E{(bf16_t*)(ws + WS_P), (const float*)(ws + WS_MOD) + 2048};
        gemm_phase<EpiP, StaticOrder, true, true>(lds, g, S, E); }
    SEAM(13);
    if (IN(14)) fnorm_phase(a);
    SEAM(14);
    if (IN(15)) {
        Gemm g{(const bf16_t*)(ws + WS_F), (const bf16_t*)(ws + WS_WF1), M_LAT, NF1, 1024}; StaticOrder S; S.init(M_LAT, NF1, G, bx);
        EpiFF1 E{(bf16_t*)(ws + WS_ACT)};
        gemm_phase<EpiFF1, StaticOrder, true, true>(lds, g, S, E); }
    SEAM(15);
    if (IN(16)) {
        Gemm g{(const bf16_t*)(ws + WS_ACT), (const bf16_t*)(ws + WS_WF2), M_LAT, 1024, DFF}; StaticOrder S; S.init(M_LAT, 1024, G, bx);
        EpiP E{(bf16_t*)(ws + WS_P), (const float*)(ws + WS_MOD) + 5120};
        gemm_phase<EpiP, StaticOrder, true, true>(lds, g, S, E); }
    SEAM(16);
    if (IN(17)) final_phase(a);
#undef IN
#undef SEAM
}

extern "C" void kernel_launch(void* const* d_in, const int* in_sizes, int n_in, void* d_out, int out_size, void* d_ws, size_t ws_size, hipStream_t stream) {
    static int grid = 0;
    if (grid == 0) {
        int dev = 0, cus = 0, per_cu = 0;
        if (hipGetDevice(&dev) != hipSuccess || hipDeviceGetAttribute(&cus, hipDeviceAttributeMultiprocessorCount, dev) != hipSuccess) { fprintf(stderr, "kernel_launch: device query failed\n"); grid = -1; return; }
        if (hipFuncSetAttribute((const void*)fwd_kernel, hipFuncAttributeMaxDynamicSharedMemorySize, LDS_BYTES) != hipSuccess) { fprintf(stderr, "kernel_launch: hipFuncSetAttribute(%d) failed\n", LDS_BYTES); grid = -1; return; }
        if (hipOccupancyMaxActiveBlocksPerMultiprocessor(&per_cu, (const void*)fwd_kernel, 512, LDS_BYTES) != hipSuccess || per_cu < 1) { fprintf(stderr, "kernel_launch: occupancy query says %d\n", per_cu); per_cu = 1; }
        (void)hipGetLastError();
        grid = 256;
        if (cus < 256) { fprintf(stderr, "kernel_launch: this kernel needs 256 CUs (found %d)\n", cus); grid = -1; return; }
        fprintf(stderr, "kernel_launch: cus %d per_cu %d ws %zu n_in %d\n", cus, per_cu, ws_size, n_in);
        if (ws_size < WS_END || n_in != 26) { fprintf(stderr, "kernel_launch: unexpected ws_size/n_in\n"); }
    }
    if (grid < 0) return;
    if (hipMemsetAsync((char*)d_ws + WS_CTL, 0, 64 * 1024, stream) != hipSuccess) { fprintf(stderr, "kernel_launch: memset failed\n"); return; }
    Args a{};
    for (int i = 0; i < 26; ++i) a.in[i] = (const float*)d_in[i];
    a.out = (float*)d_out; a.ws = (unsigned char*)d_ws;
#if MK_PER_PHASE
    for (int ph = 0; ph <= 17; ++ph) { a.ph_lo = ph; a.ph_hi = ph + 1; hipLaunchKernelGGL(fwd_kernel, dim3(grid), dim3(512), LDS_BYTES, stream, a); }
#else
    a.ph_lo = 0; a.ph_hi = 18;
    void* args[] = {&a};
    hipError_t e = hipLaunchCooperativeKernel((void*)fwd_kernel, dim3(grid), dim3(512), args, LDS_BYTES, stream);
    if (e != hipSuccess) fprintf(stderr, "cooperative launch failed: %s (grid %d)\n", hipGetErrorString(e), grid);
#endif
}
```

```cpp
#include <hip/hip_runtime.h>
#include <hip/hip_cooperative_groups.h>
#include <cstdio>
#include <cstdint>
namespace cg = cooperative_groups;


#ifndef MK_PER_PHASE
#define MK_PER_PHASE 0
#endif

#define LAS __attribute__((address_space(3)))
typedef unsigned short bf16_t;
typedef short bf16x8 __attribute__((ext_vector_type(8)));
typedef short bf16x4 __attribute__((ext_vector_type(4)));
typedef float f32x4 __attribute__((ext_vector_type(4)));
typedef float f32x2 __attribute__((ext_vector_type(2)));
typedef unsigned u32x4 __attribute__((ext_vector_type(4)));
typedef unsigned u32x2 __attribute__((ext_vector_type(2)));

constexpr int NB = 4, SEQ = 8192, DM = 1024, CTXL = 256;
constexpr int M_LAT = NB * SEQ, M_CTX = NB * CTXL, M_ALL = M_LAT + M_CTX;
constexpr int NCH_LAT = M_LAT / 64, NCH = M_ALL / 64;
constexpr int D_IN = 11360, N1A = 3328, N1B = 3072, NZ = 5120, DFF = 2816, NF1 = 2 * DFF;
constexpr int QKV_LD = 3072, XBC_LD = 3072, SMALL_LD = 96;
constexpr float EPS = 1e-6f;

constexpr size_t MiB = 1u << 20;
constexpr size_t WS_CTL = 0;
constexpr size_t WS_MOD = 1 * MiB;
constexpr size_t WS_PAR = 1 * MiB + 512 * 1024;
constexpr size_t WS_OST = 2 * MiB;
constexpr size_t WS_RAT = 12 * MiB;
constexpr size_t WS_OST_UNUSED = 0;
constexpr size_t WS_PS = 3 * MiB;
constexpr size_t WS_GC = 3 * MiB;
constexpr size_t WS_W1A = 14 * MiB;
constexpr size_t WS_W1B = WS_W1A + (size_t)N1A * 1024 * 2;
constexpr size_t WS_WZ = WS_W1B + (size_t)N1B * 1024 * 2;
constexpr size_t WS_WBG = WS_WZ + (size_t)NZ * 1024 * 2;
constexpr size_t WS_WBS = WS_WBG + (size_t)1024 * 1024 * 2;
constexpr size_t WS_WO = WS_WBS + (size_t)1024 * 2048 * 2;
constexpr size_t WS_WF1 = WS_WO + (size_t)1024 * 1024 * 2;
constexpr size_t WS_WF2 = WS_WF1 + (size_t)NF1 * 1024 * 2;
constexpr size_t WS_WEND = WS_WF2 + (size_t)1024 * DFF * 2;
static_assert(WS_WEND <= 61 * MiB, "weights");
constexpr size_t WS_SMALL = 61 * MiB;
constexpr size_t WS_A = 74 * MiB;
constexpr size_t WS_BIG = 140 * MiB;
constexpr size_t WS_QKV = WS_BIG;
constexpr size_t WS_XBC = WS_BIG;
constexpr size_t WS_TA = 338 * MiB;
constexpr size_t WS_XCT = 470 * MiB;
constexpr size_t WS_Y = 384 * MiB;
constexpr size_t WS_GATES = 140 * MiB;
constexpr size_t WS_M1 = 268 * MiB;
constexpr size_t WS_P = 140 * MiB;
constexpr size_t WS_H1 = 204 * MiB;
constexpr size_t WS_F = 268 * MiB;
constexpr size_t WS_ACT = 336 * MiB;
constexpr size_t WS_END = 512 * MiB;

constexpr int LDS_BYTES = 160 * 1024;
constexpr int RING_BYTES = 131072;
constexpr int XL_OFF = RING_BYTES;

typedef __bf16 bf16x2_t __attribute__((ext_vector_type(2)));
__device__ __forceinline__ unsigned cvt_pk_bf16(float lo, float hi) { const f32x2 v = {lo, hi}; const bf16x2_t b = __builtin_convertvector(v, bf16x2_t); return __builtin_bit_cast(unsigned, b); }
__device__ __forceinline__ float bf2f(unsigned short h) { return __uint_as_float((unsigned)h << 16); }
__device__ __forceinline__ float bflo(unsigned w) { return __uint_as_float(w << 16); }
__device__ __forceinline__ float bfhi(unsigned w) { return __uint_as_float(w & 0xffff0000u); }
__device__ __forceinline__ bf16_t f2bf(float f) { return (bf16_t)(cvt_pk_bf16(f, 0.f) & 0xffffu); }
__device__ __forceinline__ float sigmoidf_(float x) { return __builtin_amdgcn_rcpf(1.f + __expf(-x)); }
__device__ __forceinline__ float siluf_(float x) { return x * __builtin_amdgcn_rcpf(1.f + __expf(-x)); }
__device__ __forceinline__ float softplusf_(float x) { return fmaxf(x, 0.f) + __logf(1.f + __expf(-fabsf(x))); }
__device__ __forceinline__ float wave_sum(float v) {
#pragma unroll
    for (int o = 1; o < 64; o <<= 1) v += __shfl_xor(v, o);
    return v;
}
__device__ __forceinline__ void unpack8(u32x4 w, float (&f)[8]) { f[0] = bflo(w.x); f[1] = bfhi(w.x); f[2] = bflo(w.y); f[3] = bfhi(w.y); f[4] = bflo(w.z); f[5] = bfhi(w.z); f[6] = bflo(w.w); f[7] = bfhi(w.w); }
__device__ __forceinline__ u32x4 pack8(const float (&f)[8]) { u32x4 w; w.x = cvt_pk_bf16(f[0], f[1]); w.y = cvt_pk_bf16(f[2], f[3]); w.z = cvt_pk_bf16(f[4], f[5]); w.w = cvt_pk_bf16(f[6], f[7]); return w; }

namespace pg8 {
#define PG8_LAS __attribute__((address_space(3)))
constexpr int BM = 256, BK = 64, HALF = 128, HTB = HALF * BK * 2  , STAGE_BYTES = 8 * HTB, NXCD = 8, WGM = 8;
__host__ __device__ __forceinline__ int lds_byte(int r, int c) { const int st = (r >> 4) * 2 + (c >> 5), rr = r & 15, cc = c & 31, ob = rr * 64 + cc * 2; return st * 1024 + (ob ^ (((ob >> 9) & 1) << 5)); }
__host__ __device__ __forceinline__ void stage_rc(int b, int& R, int& C) { const int st = b / 1024, sb = b % 1024, swz = sb ^ (((sb >> 9) & 1) << 5); R = (st >> 1) * 16 + swz / 64; C = (st & 1) * 32 + (swz % 64) / 2; }
__host__ __device__ __forceinline__ int perm32(int rho) { const int n = rho >> 4, i = rho & 15; return 8 * (i >> 2) + 4 * n + (i & 3); }
struct Unit { int pm, pn; };
struct Gemm { const bf16_t* A; const bf16_t* Bt; int M, N, K; };
struct StaticOrder {
    int nM, nN, nwg, G, c;
    __host__ __device__ void init(int M, int N, int G_, int c_) { nM = M / BM; nN = N / BM; nwg = nM * nN; G = G_; c = c_; }
    __host__ __device__ bool next(int i, Unit& u) const {
        const long L = (long)i * G + c; if (L >= nwg) return false;
        int wgid = (int)L; { const int q = nwg / NXCD, r = nwg % NXCD, xcd = wgid % NXCD, off = wgid / NXCD; wgid = (xcd < r ? xcd * (q + 1) : r * (q + 1) + (xcd - r) * q) + off; }
        const int nig = WGM * nN, gid = wgid / nig, fm = gid * WGM, gsz = (nM - fm) < WGM ? (nM - fm) : WGM;
        u.pm = fm + ((wgid % nig) % gsz); u.pn = (wgid % nig) / gsz; return true;
    }
    __device__ __forceinline__ void a_ready(const Unit&) const {}
    __device__ __forceinline__ void done(const Unit&) const {}
};
template <class Epi, class Sched, bool ALIGN_EPI = false, bool SP2 = false>
__device__ __forceinline__ void gemm_phase(PG8_LAS unsigned char* lds, const Gemm g, const Sched& S, const Epi& E) {
    const int tid = threadIdx.x, wid = __builtin_amdgcn_readfirstlane(tid >> 6), lane = tid & 63, wr = wid >> 2, wc = wid & 3, fr = lane & 15, fq = lane >> 4;
    const int K = g.K, nt = K / BK;
    unsigned voffA[2], voffB[2];
#pragma unroll
    for (int i = 0; i < 2; ++i) { int R, C; stage_rc(tid * 16 + i * 8192, R, C); const int Rb = Epi::PERM ? ((R & ~31) + perm32(R & 31)) : R;
        voffA[i] = (unsigned)(R * K + C) * 2u; voffB[i] = (unsigned)(Rb * K + C) * 2u; }
    const size_t kstep = (size_t)(BK * 2);
    const size_t hstep = (size_t)HALF * K * 2;
    const size_t tstep = 2 * hstep;
    const unsigned ldsw = (unsigned)wid * 1024u;
    const int aoff = lds_byte(wr * 64 + fr, fq * 8), boff = lds_byte(wc * 32 + fr, fq * 8);
#define PG8_SA(b, h) (((b) * 2 + (h)) * HTB)
#define PG8_SB(b, h) ((4 + (b) * 2 + (h)) * HTB)
#define PG8_STAGE(bufoff, gbase, voff) do { _Pragma("unroll") for (int _i = 0; _i < 2; ++_i) \
        __builtin_amdgcn_global_load_lds((const unsigned*)((const char*)(gbase) + (voff)[_i]), (PG8_LAS unsigned*)(lds + (bufoff) + ldsw + _i * 8192), 16, 0, 0); } while (0)
#define PG8_LDA(dst, b, h) do { _Pragma("unroll") for (int m = 0; m < 4; ++m) _Pragma("unroll") for (int k = 0; k < 2; ++k) dst[m][k] = *(const PG8_LAS bf16x8*)(lds + PG8_SA(b, h) + aoff + m * 2048 + k * 1024); } while (0)
#define PG8_LDB(dst, b, h) do { _Pragma("unroll") for (int n = 0; n < 2; ++n) _Pragma("unroll") for (int k = 0; k < 2; ++k) dst[n][k] = *(const PG8_LAS bf16x8*)(lds + PG8_SB(b, h) + boff + n * 2048 + k * 1024); } while (0)
#define PG8_MMA(ai, bj, At, Bt) do { __builtin_amdgcn_s_setprio(1); _Pragma("unroll") for (int m = 0; m < 4; ++m) _Pragma("unroll") for (int n = 0; n < 2; ++n) _Pragma("unroll") for (int k = 0; k < 2; ++k) \
        acc[ai][bj][m][n] = __builtin_amdgcn_mfma_f32_16x16x32_bf16(Bt[n][k], At[m][k], acc[ai][bj][m][n], 0, 0, 0); __builtin_amdgcn_s_setprio(0); } while (0)
#define PG8_WAIT_V(n) asm volatile("s_waitcnt vmcnt(" #n ")" ::: "memory")
#define PG8_WAIT_L(n) asm volatile("s_waitcnt lgkmcnt(" #n ")" ::: "memory")
#define PG8_BAR __builtin_amdgcn_s_barrier()
#define PG8_SCHED __builtin_amdgcn_sched_barrier(0)
    Unit cur, nxt; int ui = 0;
    if (!S.next(0, cur)) return;
#ifdef PG8_STAGGER
    { const int g_ = (blockIdx.x >> 3) & 3; for (int i_ = 0; i_ < g_ * PG8_STAGGER; ++i_) __builtin_amdgcn_s_sleep(127); }
#endif
    f32x4 acc[2][2][4][2];
#pragma unroll
    for (int a = 0; a < 2; ++a)
#pragma unroll
        for (int b = 0; b < 2; ++b)
#pragma unroll
            for (int m = 0; m < 4; ++m)
#pragma unroll
                for (int n = 0; n < 2; ++n) acc[a][b][m][n] = (f32x4){0.f, 0.f, 0.f, 0.f};
    bf16x8 At[4][2], B0[2][2], B1[2][2];
    const char* cA = (const char*)g.A + (size_t)cur.pm * tstep; const char* cB = (const char*)g.Bt + (size_t)cur.pn * tstep;
    S.a_ready(cur);
    if constexpr (SP2) {
        PG8_STAGE(PG8_SB(0, 0), cB, voffB); PG8_STAGE(PG8_SB(0, 1), cB + hstep, voffB); PG8_STAGE(PG8_SA(0, 0), cA, voffA); PG8_STAGE(PG8_SA(0, 1), cA + hstep, voffA);
        if (wr == 1) PG8_BAR;
        PG8_WAIT_V(2); PG8_BAR;
        PG8_STAGE(PG8_SB(1, 0), cB + kstep, voffB); PG8_STAGE(PG8_SA(1, 0), cA + kstep, voffA); PG8_STAGE(PG8_SB(1, 1), cB + hstep + kstep, voffB);
        PG8_WAIT_V(6); PG8_BAR;
    } else {
        PG8_STAGE(PG8_SB(0, 0), cB, voffB); PG8_STAGE(PG8_SA(0, 0), cA, voffA); PG8_STAGE(PG8_SB(0, 1), cB + hstep, voffB); PG8_STAGE(PG8_SA(0, 1), cA + hstep, voffA);
        if (wr == 1) PG8_BAR;
        PG8_WAIT_V(4); PG8_BAR;
        PG8_STAGE(PG8_SB(1, 0), cB + kstep, voffB); PG8_STAGE(PG8_SA(1, 0), cA + kstep, voffA); PG8_STAGE(PG8_SB(1, 1), cB + hstep + kstep, voffB);
        PG8_WAIT_V(6); PG8_BAR;
    }
    for (;;) {
        const bool has_next = S.next(ui + 1, nxt);
        const char* nA = has_next ? (const char*)g.A + (size_t)nxt.pm * tstep : cA; const char* nB = has_next ? (const char*)g.Bt + (size_t)nxt.pn * tstep : cB;
        for (int t = 0; t < nt; t += 2) {
            const bool last = (t == nt - 2);
            const char* a1 = cA + (size_t)(t + 1) * kstep;
            const char* a2 = last ? nA : cA + (size_t)(t + 2) * kstep; const char* b2 = last ? nB : cB + (size_t)(t + 2) * kstep;
            const char* a3 = a2 + kstep; const char* b3 = b2 + kstep;
            if (last && has_next) S.a_ready(nxt);
            if constexpr (Epi::KSCALE) { if (t == 8 || t == 16 || t == 24) E.kscale(acc, cur, t >> 3, wr, fr); }
            if constexpr (SP2) {
            PG8_LDB(B0, 0, 0); PG8_LDB(B1, 0, 1); PG8_SCHED; PG8_LDA(At, 0, 0); PG8_STAGE(PG8_SA(1, 1), a1 + hstep, voffA);
            PG8_WAIT_V(8); PG8_WAIT_L(0); PG8_BAR; PG8_MMA(0, 0, At, B0); PG8_MMA(0, 1, At, B1); PG8_BAR; PG8_SCHED;
            PG8_LDA(At, 0, 1); PG8_STAGE(PG8_SB(0, 0), b2, voffB); PG8_STAGE(PG8_SB(0, 1), b2 + hstep, voffB); PG8_STAGE(PG8_SA(0, 0), a2, voffA);
            PG8_WAIT_V(8); PG8_WAIT_L(0); PG8_BAR; PG8_MMA(1, 0, At, B0); PG8_MMA(1, 1, At, B1); PG8_BAR; PG8_SCHED;
            PG8_LDB(B0, 1, 0); PG8_LDB(B1, 1, 1); PG8_SCHED; PG8_LDA(At, 1, 0); PG8_STAGE(PG8_SA(0, 1), a2 + hstep, voffA);
            PG8_WAIT_V(8); PG8_WAIT_L(0); PG8_BAR; PG8_MMA(0, 0, At, B0); PG8_MMA(0, 1, At, B1); PG8_BAR; PG8_SCHED;
            PG8_LDA(At, 1, 1); PG8_STAGE(PG8_SB(1, 0), b3, voffB); PG8_STAGE(PG8_SB(1, 1), b3 + hstep, voffB); PG8_STAGE(PG8_SA(1, 0), a3, voffA);
            PG8_WAIT_V(8); PG8_WAIT_L(0); PG8_BAR; PG8_MMA(1, 0, At, B0); PG8_MMA(1, 1, At, B1); PG8_BAR; PG8_SCHED;
            } else {
            PG8_LDB(B0, 0, 0); PG8_SCHED; PG8_LDA(At, 0, 0); PG8_STAGE(PG8_SA(1, 1), a1 + hstep, voffA);
            PG8_WAIT_L(8); PG8_BAR; PG8_WAIT_L(0); PG8_MMA(0, 0, At, B0); PG8_BAR; PG8_SCHED;
            PG8_LDB(B1, 0, 1); PG8_STAGE(PG8_SB(0, 0), b2, voffB);
            PG8_BAR; PG8_WAIT_L(0); PG8_MMA(0, 1, At, B1); PG8_BAR;
            PG8_LDA(At, 0, 1); PG8_STAGE(PG8_SA(0, 0), a2, voffA);
            PG8_BAR; PG8_WAIT_L(0); PG8_MMA(1, 0, At, B0); PG8_BAR; PG8_SCHED;
            PG8_STAGE(PG8_SB(0, 1), b2 + hstep, voffB);
            PG8_WAIT_V(6); PG8_BAR; PG8_MMA(1, 1, At, B1); PG8_BAR;
            PG8_LDB(B0, 1, 0); PG8_SCHED; PG8_LDA(At, 1, 0); PG8_STAGE(PG8_SA(0, 1), a2 + hstep, voffA);
            PG8_WAIT_L(8); PG8_BAR; PG8_WAIT_L(0); PG8_MMA(0, 0, At, B0); PG8_BAR; PG8_SCHED;
            PG8_LDB(B1, 1, 1); PG8_STAGE(PG8_SB(1, 0), b3, voffB);
            PG8_BAR; PG8_WAIT_L(0); PG8_MMA(0, 1, At, B1); PG8_BAR;
            PG8_LDA(At, 1, 1); PG8_STAGE(PG8_SA(1, 0), a3, voffA);
            PG8_BAR; PG8_WAIT_L(0); PG8_MMA(1, 0, At, B0); PG8_BAR; PG8_SCHED;
            PG8_STAGE(PG8_SB(1, 1), b3 + hstep, voffB);
            PG8_WAIT_V(6); PG8_BAR; PG8_MMA(1, 1, At, B1); PG8_BAR;
            }
        }
        if constexpr (ALIGN_EPI) { if (wr == 0) PG8_BAR; }
        if constexpr (!Epi::AFTER_DRAIN) { E(acc, cur, wr, wc, fr, fq); S.done(cur); }
        if (!has_next) break;
#pragma unroll
        for (int a = 0; a < 2; ++a)
#pragma unroll
            for (int b = 0; b < 2; ++b)
#pragma unroll
                for (int m = 0; m < 4; ++m)
#pragma unroll
                    for (int n = 0; n < 2; ++n) acc[a][b][m][n] = (f32x4){0.f, 0.f, 0.f, 0.f};
        cur = nxt; cA = nA; cB = nB; ++ui;
        if constexpr (ALIGN_EPI) { if (wr == 1) PG8_BAR; }
    }
    PG8_WAIT_V(0);
    if constexpr (!ALIGN_EPI) { if (wr == 0) PG8_BAR; }
    PG8_BAR;
    if constexpr (Epi::AFTER_DRAIN) { E.fused(acc, cur, wr, wc, fr, fq, lds, wid, lane); S.done(cur); }
#undef PG8_SA
#undef PG8_SB
#undef PG8_STAGE
#undef PG8_LDA
#undef PG8_LDB
#undef PG8_MMA
#undef PG8_WAIT_V
#undef PG8_WAIT_L
#undef PG8_BAR
#undef PG8_SCHED
}
}

using pg8::Unit; using pg8::HALF; using pg8::BM;
#define ACC_T const f32x4 (&acc)[2][2][4][2]
#define EPI_FOR_AI_M _Pragma("unroll") for (int ai = 0; ai < 2; ++ai) _Pragma("unroll") for (int m = 0; m < 4; ++m)
__device__ __forceinline__ void acc8(ACC_T, int ai, int bj, int m, float (&v)[8]) {
    const f32x4 a = acc[ai][bj][m][0], b = acc[ai][bj][m][1];
    v[0] = a[0]; v[1] = a[1]; v[2] = a[2]; v[3] = a[3]; v[4] = b[0]; v[5] = b[1]; v[6] = b[2]; v[7] = b[3];
}
__device__ __forceinline__ void ld8f(const float* p, float (&v)[8]) { const f32x4 a = *(const f32x4*)p, b = *(const f32x4*)(p + 4); v[0] = a[0]; v[1] = a[1]; v[2] = a[2]; v[3] = a[3]; v[4] = b[0]; v[5] = b[1]; v[6] = b[2]; v[7] = b[3]; }
__device__ __forceinline__ void st8f(float* p, const float (&v)[8]) { *(f32x4*)p = (f32x4){v[0], v[1], v[2], v[3]}; *(f32x4*)(p + 4) = (f32x4){v[4], v[5], v[6], v[7]}; }
__device__ __forceinline__ void ld8b(const bf16_t* p, float (&v)[8]) { unpack8(*(const u32x4*)p, v); }
__device__ __forceinline__ void st8b(bf16_t* p, const float (&v)[8]) { *(u32x4*)p = pack8(v); }
__device__ __forceinline__ float fq_sum(float s) { s += __shfl_xor(s, 16); s += __shfl_xor(s, 32); return s; }

__device__ __forceinline__ float rot_prev(float v) { return __builtin_bit_cast(float, __builtin_amdgcn_update_dpp(0, __builtin_bit_cast(int, v), 0x121, 0xf, 0xf, false)); }
__device__ __forceinline__ float rot_next(float v) { return __builtin_bit_cast(float, __builtin_amdgcn_update_dpp(0, __builtin_bit_cast(int, v), 0x12f, 0xf, 0xf, false)); }
struct EpiConv {
    static constexpr bool PERM = true, AFTER_DRAIN = false, KSCALE = false;
    bf16_t* out; int ldc; const float* cw; const float* cb; int nconv_tiles;
    float* small; const float* par;
    LAS float* xl;
    __device__ __forceinline__ void operator()(ACC_T, const Unit& u, int wr, int wc, int fr_in, int fq_in) const {
        int fr = fr_in, fq = fq_in; asm volatile("" : "+v"(fr), "+v"(fq));
        const int lane = fr + 16 * fq;
        if (u.pn < nconv_tiles) {
            const bool ctx = u.pm >= (M_LAT / BM);
            {
                const int t = threadIdx.x, arr = t >> 7, c2 = 2 * (t & 127);
                const float* src = (arr < 3 ? cw + arr * ldc : cb) + u.pn * BM + c2;
                *(LAS f32x2*)(xl + 2048 + arr * 256 + c2) = *(const f32x2*)src;
            }
            if (ctx) {
#pragma unroll
                for (int ai = 0; ai < 2; ++ai) { const int g = 2 * ai + wr;
#pragma unroll
                    for (int bj = 0; bj < 2; ++bj) { const int c = 128 * bj + 32 * wc + 8 * fq; float v[8];
                        if (fr == 0) { acc8(acc, ai, bj, 0, v);
#pragma unroll
                            for (int e = 0; e < 8; ++e) xl[(g * 2 + 0) * 256 + c + e] = v[e]; }
                        if (fr == 15) { acc8(acc, ai, bj, 3, v);
#pragma unroll
                            for (int e = 0; e < 8; ++e) xl[(g * 2 + 1) * 256 + c + e] = v[e]; } } }
            }
            asm volatile("s_waitcnt vmcnt(0) lgkmcnt(0)" ::: "memory"); __builtin_amdgcn_s_barrier(); asm volatile("" ::: "memory");
#pragma unroll
            for (int bj = 0; bj < 2; ++bj) {
                const int ct = 128 * bj + 32 * wc + 8 * fq, c0 = u.pn * BM + ct;
#pragma unroll
                for (int ai = 0; ai < 2; ++ai) {
                    const int g = 2 * ai + wr;
                    unsigned pk[4][4];
#pragma unroll
                    for (int hf = 0; hf < 2; ++hf) {
                        const LAS float* wl = xl + 2048 + ct + 4 * hf; const f32x4 w0 = *(const LAS f32x4*)wl, w1 = *(const LAS f32x4*)(wl + 256), w2 = *(const LAS f32x4*)(wl + 512), bb = *(const LAS f32x4*)(wl + 768);
                        f32x4 bp = {0.f, 0.f, 0.f, 0.f}, bn = {0.f, 0.f, 0.f, 0.f};
                        if (ctx) {
                            if (g > 0 && fr == 0) bp = *(const LAS f32x4*)(xl + ((g - 1) * 2 + 1) * 256 + ct + 4 * hf);
                            if (g < 3 && fr == 15) bn = *(const LAS f32x4*)(xl + ((g + 1) * 2 + 0) * 256 + ct + 4 * hf);
                        }
                        f32x4 Rm1 = bp, Xc = acc[ai][bj][0][hf], Lc;
#pragma unroll
                        for (int e = 0; e < 4; ++e) Lc[e] = rot_next(Xc[e]);
#pragma unroll
                        for (int m = 0; m < 4; ++m) {
                            f32x4 Rc, Ln = bn, Xn = Xc, o;
                            if (m < 3) Xn = acc[ai][bj][m < 3 ? m + 1 : 3][hf];
#pragma unroll
                            for (int e = 0; e < 4; ++e) { Rc[e] = rot_prev(Xc[e]); if (m < 3) Ln[e] = rot_next(Xn[e]); }
#pragma unroll
                            for (int e = 0; e < 4; ++e) {
                                const float pv = (fr > 0) ? Rc[e] : Rm1[e];
                                const float nv = (fr < 15) ? Lc[e] : Ln[e];
                                o[e] = siluf_(bb[e] + w0[e] * pv + w1[e] * Xc[e] + w2[e] * nv);
                            }
                            pk[m][2 * hf] = cvt_pk_bf16(o[0], o[1]); pk[m][2 * hf + 1] = cvt_pk_bf16(o[2], o[3]);
                            Rm1 = Rc; Lc = Ln; Xc = Xn;
                        }
                    }
#pragma unroll
                    for (int m = 0; m < 4; ++m) { const size_t row = (size_t)u.pm * BM + ai * HALF + wr * 64 + m * 16 + fr;
                        *(u32x4*)(out + row * ldc + c0) = (u32x4){pk[m][0], pk[m][1], pk[m][2], pk[m][3]}; }
                }
            }
        } else {
            if (wc < 3) {
                const int c0 = 32 * wc + 8 * fq; const bool is_beta = (c0 >= 16) && (c0 < 32);
                float p0[8], p1[8]; ld8f(par + c0, p0); ld8f(par + 96 + c0, p1);
                EPI_FOR_AI_M {
                    float v[8], o[8]; acc8(acc, ai, 0, m, v);
#pragma unroll
                    for (int e = 0; e < 8; ++e) o[e] = is_beta ? sigmoidf_(v[e]) : p0[e] * softplusf_(v[e] + p1[e]);
                    const size_t row = (size_t)u.pm * BM + ai * HALF + wr * 64 + m * 16 + fr;
                    st8f(small + row * SMALL_LD + c0, o);
                }
            }
        }
    }
};

struct EpiZ {
    static constexpr bool PERM = true, AFTER_DRAIN = false, KSCALE = false;
    bf16_t* of; const bf16_t* ob; const float* ost; const float* gnw;
    bf16_t* y; float* ps;
    bf16_t* gates;
    __device__ __forceinline__ void operator()(ACC_T, const Unit& u, int wr, int wc, int fr, int fq) const {
        const size_t row0 = (size_t)u.pm * BM + wr * 64 + fr;
        if (u.pn < 4) {
#pragma unroll
            for (int bj = 0; bj < 2; ++bj) {
                const int c0 = u.pn * BM + 128 * bj + 32 * wc + 8 * fq, head = 2 * u.pn + bj; float w[8]; ld8f(gnw + (c0 & 127), w);
#pragma unroll
                for (int hf = 0; hf < 2; ++hf) {
                    u32x4 a[4], b[4]; float rs[4];
#pragma unroll
                    for (int m = 0; m < 4; ++m) { const size_t row = row0 + hf * HALF + m * 16; a[m] = __builtin_nontemporal_load((const u32x4*)(of + row * 1024 + c0)); b[m] = __builtin_nontemporal_load((const u32x4*)(ob + row * 1024 + c0)); rs[m] = ost[row * 8 + head]; }
#pragma unroll
                    for (int m = 0; m < 4; ++m) { const size_t row = row0 + hf * HALF + m * 16;
                        float z[8], fa[8], fb[8], o[8]; acc8(acc, hf, bj, m, z); unpack8(a[m], fa); unpack8(b[m], fb);
#pragma unroll
                        for (int e = 0; e < 8; ++e) o[e] = (fa[e] + fb[e]) * rs[m] * w[e] * siluf_(z[e]);
                        st8b(of + row * 1024 + c0, o); }
                }
            }
        } else if (u.pn < 12) {
#pragma unroll
            for (int bj = 0; bj < 2; ++bj) {
                const int c0 = (u.pn - 4) * BM + 128 * bj + 32 * wc + 8 * fq;
                u32x4 a[8];
#pragma unroll
                for (int g = 0; g < 8; ++g) { const size_t row = row0 + (g >> 2) * HALF + (g & 3) * 16; a[g] = __builtin_nontemporal_load((const u32x4*)(y + row * 2048 + c0)); }
#pragma unroll
                for (int g = 0; g < 8; ++g) { const size_t row = row0 + (g >> 2) * HALF + (g & 3) * 16;
                    float z[8], fa[8], o[8]; acc8(acc, g >> 2, bj, g & 3, z); unpack8(a[g], fa);
                    float sq = 0.f;
#pragma unroll
                    for (int e = 0; e < 8; ++e) { o[e] = fa[e] * siluf_(z[e]); sq += o[e] * o[e]; }
                    st8b(y + row * 2048 + c0, o);
                    sq = fq_sum(sq);
                    if (fq == 0) ps[row * 64 + (c0 >> 5)] = sq; }
            }
        } else {
#pragma unroll
            for (int bj = 0; bj < 2; ++bj) {
                const int c0 = (u.pn - 12) * BM + 128 * bj + 32 * wc + 8 * fq;
                EPI_FOR_AI_M {
                    const size_t row = (size_t)u.pm * BM + ai * HALF + wr * 64 + m * 16 + fr;
                    float z[8], o[8]; acc8(acc, ai, bj, m, z);
#pragma unroll
                    for (int e = 0; e < 8; ++e) o[e] = sigmoidf_(z[e]);
                    st8b(gates + row * 2048 + c0, o);
                }
            }
        }
    }
};

template <int SECOND> struct EpiBR {
    static constexpr bool PERM = true, AFTER_DRAIN = false, KSCALE = SECOND != 0;
    const bf16_t* gates; bf16_t* m1; bf16_t* merged; const float* rat;
    __device__ __forceinline__ void kscale(f32x4 (&acc)[2][2][4][2], const Unit& u, int g, int wr, int fr) const {
#pragma unroll
        for (int ai = 0; ai < 2; ++ai)
#pragma unroll
            for (int m = 0; m < 4; ++m) { const float r = rat[((size_t)u.pm * BM + ai * HALF + wr * 64 + m * 16 + fr) * 4 + (g - 1)];
#pragma unroll
                for (int bj = 0; bj < 2; ++bj)
#pragma unroll
                    for (int n = 0; n < 2; ++n) acc[ai][bj][m][n] = acc[ai][bj][m][n] * r; }
    }
    __device__ __forceinline__ void operator()(ACC_T, const Unit& u, int wr, int wc, int fr, int fq) const {
        const size_t row0 = (size_t)u.pm * BM + wr * 64 + fr;
#pragma unroll
        for (int bj = 0; bj < 2; ++bj) {
            const int c0 = u.pn * BM + 128 * bj + 32 * wc + 8 * fq;
#pragma unroll
            for (int hf = 0; hf < 2; ++hf) {
                u32x4 gv[4], av[4];
#pragma unroll
                for (int m = 0; m < 4; ++m) { const size_t row = row0 + hf * HALF + m * 16; gv[m] = __builtin_nontemporal_load((const u32x4*)(gates + row * 2048 + (SECOND ? 1024 : 0) + c0)); if (SECOND) av[m] = __builtin_nontemporal_load((const u32x4*)(m1 + row * 1024 + c0)); }
#pragma unroll
                for (int m = 0; m < 4; ++m) { const size_t row = row0 + hf * HALF + m * 16;
                    float p[8], gg[8], o[8]; acc8(acc, hf, bj, m, p); unpack8(gv[m], gg);
                    if (SECOND) { float a[8]; unpack8(av[m], a); const float r3 = rat[row * 4 + 3];
#pragma unroll
                        for (int e = 0; e < 8; ++e) o[e] = a[e] + gg[e] * (p[e] * r3);
                        st8b(merged + row * 1024 + c0, o);
                    } else {
#pragma unroll
                        for (int e = 0; e < 8; ++e) o[e] = gg[e] * p[e];
                        st8b(m1 + row * 1024 + c0, o);
                    } }
            }
        }
    }
};

template <bool IN_BF, bool OUT_BF> struct EpiRes {
    static constexpr bool PERM = true, AFTER_DRAIN = false, KSCALE = false;
    const void* base_; void* out_; const float* gate; float* ps;
    __device__ __forceinline__ void operator()(ACC_T, const Unit& u, int wr, int wc, int fr, int fq) const {
        const int b = u.pm / (SEQ / BM); const size_t row0 = (size_t)u.pm * BM + wr * 64 + fr;
#pragma unroll
        for (int bj = 0; bj < 2; ++bj) {
            const int c0 = u.pn * BM + 128 * bj + 32 * wc + 8 * fq; float g[8]; ld8f(gate + (size_t)b * 6144 + c0, g);
#pragma unroll
            for (int hf = 0; hf < 2; ++hf) {
                f32x4 x0[4], x1[4];
#pragma unroll
                for (int m = 0; m < 4; ++m) { const size_t row = row0 + hf * HALF + m * 16;
                    if constexpr (IN_BF) { float t[8]; ld8b((const bf16_t*)base_ + row * 1024 + c0, t); x0[m] = (f32x4){t[0], t[1], t[2], t[3]}; x1[m] = (f32x4){t[4], t[5], t[6], t[7]}; }
                    else { const float* base = (const float*)base_; x0[m] = *(const f32x4*)(base + row * 1024 + c0); x1[m] = *(const f32x4*)(base + row * 1024 + c0 + 4); } }
#pragma unroll
                for (int m = 0; m < 4; ++m) { const size_t row = row0 + hf * HALF + m * 16;
                    float p[8], o[8]; acc8(acc, hf, bj, m, p);
                    float sq = 0.f;
#pragma unroll
                    for (int e = 0; e < 8; ++e) { o[e] = (e < 4 ? x0[m][e & 3] : x1[m][e & 3]) + g[e] * p[e]; sq += o[e] * o[e]; }
                    if constexpr (OUT_BF) st8b((bf16_t*)out_ + row * 1024 + c0, o); else st8f((float*)out_ + row * 1024 + c0, o);
                    sq = fq_sum(sq);
                    if (fq == 0) ps[row * 32 + (c0 >> 5)] = sq; }
            }
        }
    }
};

struct EpiFF1 {
    static constexpr bool PERM = true, AFTER_DRAIN = false, KSCALE = false;
    bf16_t* act;
    __device__ __forceinline__ void operator()(ACC_T, const Unit& u, int wr, int wc, int fr, int fq) const {
        const int c0 = u.pn * 128 + 32 * wc + 8 * fq;
        EPI_FOR_AI_M {
            const size_t row = (size_t)u.pm * BM + ai * HALF + wr * 64 + m * 16 + fr;
            float g[8], up[8], o[8]; acc8(acc, ai, 0, m, g); acc8(acc, ai, 1, m, up);
#pragma unroll
            for (int e = 0; e < 8; ++e) o[e] = siluf_(g[e]) * up[e];
            st8b(act + row * DFF + c0, o);
        }
    }
};

struct EpiP {
    static constexpr bool PERM = true, AFTER_DRAIN = false, KSCALE = false;
    bf16_t* out; const float* gate;
    __device__ __forceinline__ void operator()(ACC_T, const Unit& u, int wr, int wc, int fr, int fq) const {
        const int b = u.pm / (SEQ / BM);
#pragma unroll
        for (int bj = 0; bj < 2; ++bj) {
            const int c0 = u.pn * BM + 128 * bj + 32 * wc + 8 * fq; float g[8]; ld8f(gate + (size_t)b * 6144 + c0, g);
            EPI_FOR_AI_M {
                const size_t row = (size_t)u.pm * BM + ai * HALF + wr * 64 + m * 16 + fr;
                float p[8], o[8]; acc8(acc, ai, bj, m, p);
#pragma unroll
                for (int e = 0; e < 8; ++e) o[e] = g[e] * p[e];
                st8b(out + row * 1024 + c0, o);
            }
        }
    }
};

struct EpiNull {
    static constexpr bool PERM = true, AFTER_DRAIN = false, KSCALE = false;
    __device__ __forceinline__ void operator()(ACC_T, const Unit& u, int wr, int wc, int fr, int fq) const {
#pragma unroll
        for (int ai = 0; ai < 2; ++ai)
#pragma unroll
            for (int bj = 0; bj < 2; ++bj)
#pragma unroll
                for (int m = 0; m < 4; ++m) { asm volatile("" :: "v"(acc[ai][bj][m][0])); asm volatile("" :: "v"(acc[ai][bj][m][1])); }
    }
};

struct Args {
    const float* in[26];
    float* out; unsigned char* ws;
    int ph_lo, ph_hi;
};
enum In { I_X = 0, I_C, I_CTX, I_CCTX, I_ADAW, I_ADAB, I_N1W, I_WIN, I_GCW, I_GCB, I_GALOG, I_GDTB, I_GNW, I_SCW, I_SCB, I_SALOG, I_SDTB, I_SD, I_SNW, I_WBG, I_WBS, I_WO, I_N2W, I_WF1, I_WF2, I_NFW };

#define KARG_PTR(off) (*(const unsigned long long volatile __attribute__((address_space(4)))*)((const __attribute__((address_space(4))) char*)__builtin_amdgcn_kernarg_segment_ptr() + (off)))
#define GAS __attribute__((address_space(1)))
#define KIN(i) ((const float*)(const GAS float*)KARG_PTR(8 * (i)))
#define KOUT() ((float*)(GAS float*)KARG_PTR(208))
#define KWS() ((unsigned char*)(GAS unsigned char*)KARG_PTR(216))
#define LDS_WAIT() asm volatile("s_waitcnt lgkmcnt(0)" ::: "memory")

#define XB_TMO      128
#define XB_XCNT(j)  (256  + 64 * (j))
#define XB_XSUB(j)  (1280 + 64 * (j))
#define XB_XGEN(j)  (2304 + 64 * (j))
#define XB_TOP      3328
#define XB_TOPGEN   3392
#define XCD_BAR_WORDS 3456
#define XB_SPIN_CAP (1u << 18)

__device__ __forceinline__ unsigned xb_ld(unsigned* p)              { return __hip_atomic_load(p, __ATOMIC_RELAXED, __HIP_MEMORY_SCOPE_AGENT); }
__device__ __forceinline__ unsigned xb_add(unsigned* p, unsigned v) { return __hip_atomic_fetch_add(p, v, __ATOMIC_RELAXED, __HIP_MEMORY_SCOPE_AGENT); }
__device__ __forceinline__ unsigned xb_xcc_id() { return (unsigned)__builtin_amdgcn_s_getreg((3 << 11) | 20) & 0xFu; }
#define XB_SPIN(cond, bar) do { unsigned _sp = 0; while (cond) { __builtin_amdgcn_s_sleep(1); \
    if ((++_sp & 255u) == 0u) { if (xb_ld(&(bar)[XB_TMO])) break; if (_sp > XB_SPIN_CAP) { atomicAdd(&(bar)[XB_TMO], 1u); break; } } } } while (0)

struct XcdBarrier {
    unsigned* bar; unsigned x;
    volatile LAS unsigned* st;
};

__device__ __forceinline__ XcdBarrier xcd_barrier_post(unsigned* bar, volatile LAS unsigned* st) {
    XcdBarrier b; b.bar = bar; b.x = xb_xcc_id(); b.st = st;
    if (threadIdx.x == 0) (void)xb_add(&bar[XB_XCNT(b.x)], 1u);
    return b;
}
__device__ __forceinline__ void xcd_barrier_complete(unsigned* bar, unsigned x, unsigned& nloc, unsigned& nx) {
    const unsigned G = gridDim.x * gridDim.y * gridDim.z;
    unsigned sum, cnt, mine, sp = 0u;
    for (;;) {
        sum = 0u; cnt = 0u; mine = 0u;
#pragma unroll
        for (unsigned j = 0; j < 16; ++j) { const unsigned c = xb_ld(&bar[XB_XCNT(j)]); sum += c; cnt += (c > 0u) ? 1u : 0u; mine = (j == x) ? c : mine; }
        if (sum == G) break;
        __builtin_amdgcn_s_sleep(1);
        if ((++sp & 255u) == 0u) { if (xb_ld(&bar[XB_TMO])) break; if (sp > XB_SPIN_CAP) { atomicAdd(&bar[XB_TMO], 1u); break; } }
    }
    nloc = mine > 0u ? mine : 1u; nx = cnt > 0u ? cnt : 1u;
}

__device__ __forceinline__ void xcd_barrier(const XcdBarrier& b) {
    asm volatile("s_waitcnt vmcnt(0)" ::: "memory");
    __syncthreads();
    if (threadIdx.x == 0) {
        unsigned* bar = b.bar;
        __builtin_amdgcn_s_waitcnt(0);
        unsigned nloc = b.st[0], nx = b.st[1];
        if (nloc == 0u) { xcd_barrier_complete(bar, b.x, nloc, nx); b.st[0] = nloc; b.st[1] = nx; }
        const unsigned old = xb_add(&bar[XB_XSUB(b.x)], 1u);
        const unsigned gen = old / nloc;
        if (old + 1u == (gen + 1u) * nloc) {
            __builtin_amdgcn_fence(__ATOMIC_RELEASE, "agent");
            asm volatile("s_waitcnt vmcnt(0)" ::: "memory");
            const unsigned og = xb_add(&bar[XB_TOP], 1u);
            const unsigned tg = og / nx;
            if (og + 1u == (tg + 1u) * nx) xb_add(&bar[XB_TOPGEN], 1u);
            else XB_SPIN(xb_ld(&bar[XB_TOPGEN]) == tg, bar);
            __builtin_amdgcn_fence(__ATOMIC_ACQUIRE, "agent");
            xb_add(&bar[XB_XGEN(b.x)], 1u);
            asm volatile("s_waitcnt vmcnt(0)" ::: "memory");
        } else {
            XB_SPIN(xb_ld(&bar[XB_XGEN(b.x)]) == gen, bar);
            __builtin_amdgcn_fence(__ATOMIC_ACQUIRE, "agent");
            asm volatile("s_waitcnt vmcnt(0)" ::: "memory");
        }
    }
    __syncthreads();
}

__device__ __forceinline__ f32x4 mma16(bf16x8 a, bf16x8 b, f32x4 c) { return __builtin_amdgcn_mfma_f32_16x16x32_bf16(a, b, c, 0, 0, 0); }
__device__ __forceinline__ bf16x8 frag_std(const LAS bf16_t* X, int pitch, int r0, int c0, int lane) {
    return *(const LAS bf16x8*)(X + (r0 + (lane & 15)) * pitch + c0 + 8 * (lane >> 4));
}
__device__ __forceinline__ bf16x8 frag_perm(const LAS bf16_t* X, int pitch, int r0, int c0, int lane) {
    const LAS bf16_t* p = X + (r0 + (lane & 15)) * pitch + c0 + 4 * (lane >> 4);
    const bf16x4 a = *(const LAS bf16x4*)p, b = *(const LAS bf16x4*)(p + 16);
    return (bf16x8){a[0], a[1], a[2], a[3], b[0], b[1], b[2], b[3]};
}
__device__ __forceinline__ bf16x8 acc_frag(f32x4 lo, f32x4 hi) {
    u32x4 w; w.x = cvt_pk_bf16(lo[0], lo[1]); w.y = cvt_pk_bf16(lo[2], lo[3]); w.z = cvt_pk_bf16(hi[0], hi[1]); w.w = cvt_pk_bf16(hi[2], hi[3]);
    return __builtin_bit_cast(bf16x8, w);
}
__device__ __forceinline__ int chunk_row0(int ci) { return ci < NCH_LAT ? ci * 64 : M_LAT + (ci - NCH_LAT) * 64; }

__device__ __forceinline__ void transpose_item(const float* W, int Nsrc, int K, int src_c0, bf16_t* WT, int dst_r0, LAS float* scr, int kb, int lane, const float* kscale = nullptr) {
    const int k0 = 64 * kb;
#pragma unroll 8
    for (int i = 0; i < 32; ++i) { const int kk = 2 * i + (lane >> 5); scr[kk * 33 + (lane & 31)] = __builtin_nontemporal_load(W + (size_t)(k0 + kk) * Nsrc + src_c0 + (lane & 31)) * (kscale ? kscale[k0 + kk] : 1.0f); }
    LDS_WAIT(); asm volatile("" ::: "memory");
    const int c = lane & 7;
#pragma unroll
    for (int j = 0; j < 4; ++j) { const int n = (lane >> 3) + 8 * j; const LAS float* s = scr + (8 * c) * 33 + n;
        u32x4 o; o.x = cvt_pk_bf16(s[0 * 33], s[1 * 33]); o.y = cvt_pk_bf16(s[2 * 33], s[3 * 33]); o.z = cvt_pk_bf16(s[4 * 33], s[5 * 33]); o.w = cvt_pk_bf16(s[6 * 33], s[7 * 33]);
        *(u32x4*)(WT + (size_t)(dst_r0 + n) * K + k0 + 8 * c) = o; }
    LDS_WAIT(); asm volatile("" ::: "memory");
}
__device__ __forceinline__ bool seg_item(int& it, const float* W, int Nsrc, int K, int src_c0, bf16_t* WT, int dst_r0, int ncols, LAS float* scr, int lane, const float* kscale = nullptr) {
    const int nblk = ncols / 32, n_items = (K / 64) * nblk;
    if (it >= n_items) { it -= n_items; return false; }
    const int kb = it / nblk, nb = it % nblk;
    transpose_item(W, Nsrc, K, src_c0 + 32 * nb, WT, dst_r0 + 32 * nb, scr, kb, lane, kscale);
    return true;
}
constexpr int N_ITEMS_W1A = 16 * ((3072 + 32 + 64) / 32);
constexpr int N_ITEMS_W1B_END = N_ITEMS_W1A + 16 * (3072 / 32);
constexpr int N_ITEMS_ALL = 16 * (D_IN / 32) + 16 * 32 + 32 * 32 + 16 * 32 + 16 * (NF1 / 32) + 44 * 32;
__device__ __forceinline__ void weight_convert(LAS unsigned char* lds, int item_lo, int item_hi, int gw, int NGW) {
    const int lane = threadIdx.x & 63, wave = threadIdx.x >> 6; unsigned char* ws = KWS();
    LAS float* scr = (LAS float*)(lds + wave * 8704);
    const float* win = KIN(I_WIN);
    bf16_t* W1A = (bf16_t*)(ws + WS_W1A); bf16_t* W1B = (bf16_t*)(ws + WS_W1B); bf16_t* WZ = (bf16_t*)(ws + WS_WZ);
    bf16_t* WBG = (bf16_t*)(ws + WS_WBG); bf16_t* WBS = (bf16_t*)(ws + WS_WBS); bf16_t* WO = (bf16_t*)(ws + WS_WO);
    bf16_t* WF1 = (bf16_t*)(ws + WS_WF1); bf16_t* WF2 = (bf16_t*)(ws + WS_WF2);
    for (int it0 = item_lo + gw; it0 < item_hi; it0 += NGW) {
        int it = it0;
        if (seg_item(it, win, D_IN, 1024, 0, W1A, 0, 3072, scr, lane)) continue;
        if (seg_item(it, win, D_IN, 1024, 4096, W1A, 3072, 32, scr, lane)) continue;
        if (seg_item(it, win, D_IN, 1024, 9248, W1A, 3104, 64, scr, lane)) continue;
        if (seg_item(it, win, D_IN, 1024, 6176, W1B, 0, 3072, scr, lane)) continue;
        if (seg_item(it, win, D_IN, 1024, 3072, WZ, 0, 1024, scr, lane)) continue;
        if (seg_item(it, win, D_IN, 1024, 4128, WZ, 1024, 2048, scr, lane)) continue;
        if (seg_item(it, win, D_IN, 1024, 9312, WZ, 3072, 2048, scr, lane)) continue;
        if (seg_item(it, KIN(I_WBG), 1024, 1024, 0, WBG, 0, 1024, scr, lane)) continue;
        if (seg_item(it, KIN(I_WBS), 1024, 2048, 0, WBS, 0, 1024, scr, lane, KIN(I_SNW))) continue;
        if (seg_item(it, KIN(I_WO), 1024, 1024, 0, WO, 0, 1024, scr, lane)) continue;
        if (it < 16 * (NF1 / 32)) {
            const int nblk = NF1 / 32, kb = it / nblk, db = it % nblk, pn = db >> 3, wi = db & 7;
            const int src = (wi < 4) ? (128 * pn + 32 * wi) : (DFF + 128 * pn + 32 * (wi - 4));
            transpose_item(KIN(I_WF1), NF1, 1024, src, WF1, 32 * db, scr, kb, lane); continue; }
        it -= 16 * (NF1 / 32);
        seg_item(it, KIN(I_WF2), 1024, DFF, 0, WF2, 0, 1024, scr, lane);
    }
}
__device__ __forceinline__ void p0_prologue(const Args& a, LAS unsigned char* lds) {
    const int tid = threadIdx.x, lane = tid & 63, wave = tid >> 6, G = gridDim.x;
    unsigned char* ws = KWS();
    if (blockIdx.x < 96) {
        LAS float* cs = (LAS float*)(lds + 81920);
        LAS float* red = (LAS float*)(lds + 81920 + 20480);
        for (int idx = tid; idx < 5 * 1024; idx += 512) { const int r = idx >> 10, k = idx & 1023; const float v = r < 4 ? KIN(I_C)[r * 1024 + k] : KIN(I_CCTX)[k]; cs[idx] = v / (1.f + expf(-v)); }
        __syncthreads();
        const int col = 64 * blockIdx.x + lane; const float* aw = KIN(I_ADAW);
        float acc[5] = {0.f, 0.f, 0.f, 0.f, 0.f};
        for (int k0 = 128 * wave; k0 < 128 * wave + 128; k0 += 32) {
            float wv[32];
#pragma unroll
            for (int j = 0; j < 32; ++j) wv[j] = __builtin_nontemporal_load(aw + (size_t)(k0 + j) * 6144 + col);
#pragma unroll
            for (int j = 0; j < 32; ++j)
#pragma unroll
                for (int r = 0; r < 5; ++r) acc[r] += cs[r * 1024 + k0 + j] * wv[j]; }
#pragma unroll
        for (int r = 0; r < 5; ++r) red[(wave * 5 + r) * 64 + lane] = acc[r];
        __syncthreads();
        if (wave == 0) { float* mod = (float*)(ws + WS_MOD); const float bias = KIN(I_ADAB)[col];
#pragma unroll
            for (int r = 0; r < 5; ++r) { float s = bias;
#pragma unroll
                for (int w = 0; w < 8; ++w) s += red[(w * 5 + r) * 64 + lane];
                mod[r * 6144 + col] = s; } }
        __syncthreads();
    }
    if (blockIdx.x == 96 && tid < 96) {
        float* par = (float*)(ws + WS_PAR); float p0, p1;
        if (tid < 16) { p0 = -expf(KIN(I_GALOG)[tid]); p1 = KIN(I_GDTB)[tid]; } else if (tid < 32) { p0 = 0.f; p1 = 0.f; } else { p0 = 1.f; p1 = KIN(I_SDTB)[tid - 32]; }
        par[tid] = p0; par[96 + tid] = p1; }
    if (blockIdx.x >= 96) weight_convert(lds, 0, N_ITEMS_W1A, (blockIdx.x - 96) * 8 + wave, (G - 96) * 8);
    bf16_t* W1A = (bf16_t*)(ws + WS_W1A);
    { u32x4* z = (u32x4*)(W1A + (size_t)3168 * 1024); const int n16 = 160 * 1024 * 2 / 16;
      for (int i = blockIdx.x * 512 + tid; i < n16; i += G * 512) z[i] = (u32x4){0u, 0u, 0u, 0u}; }
}

__device__ __forceinline__ void p1_norm_mod(const Args& a) {
    const int lane = threadIdx.x & 63, wave = threadIdx.x >> 6; const int gw = blockIdx.x * 8 + wave, NGW = gridDim.x * 8;
    const float* mod = (const float*)(KWS() + WS_MOD); bf16_t* A = (bf16_t*)(KWS() + WS_A); const float* X = KIN(I_X); const float* CX = KIN(I_CTX);
    for (int bt = gw; bt < M_ALL / 4; bt += NGW) {
        const int row0 = 4 * bt; const float* src = row0 < M_LAT ? X + (size_t)row0 * 1024 : CX + (size_t)(row0 - M_LAT) * 1024; const int r = row0 < M_LAT ? row0 / SEQ : 4;
        f32x4 v[4][4];
#pragma unroll
        for (int i = 0; i < 4; ++i)
#pragma unroll
            for (int j = 0; j < 4; ++j) v[i][j] = __builtin_nontemporal_load((const f32x4*)(src + (size_t)i * 1024 + 4 * lane + 256 * j));
        f32x4 sc[4], sh[4];
#pragma unroll
        for (int j = 0; j < 4; ++j) { const int c = 4 * lane + 256 * j; const f32x4 w = *(const f32x4*)(KIN(I_N1W) + c), s1 = *(const f32x4*)(mod + r * 6144 + 1024 + c);
            sc[j] = w * (s1 + 1.0f); sh[j] = *(const f32x4*)(mod + r * 6144 + c); }
#pragma unroll
        for (int i = 0; i < 4; ++i) { float ss = 0.f;
#pragma unroll
            for (int j = 0; j < 4; ++j) ss += (v[i][j][0] * v[i][j][0] + v[i][j][1] * v[i][j][1]) + (v[i][j][2] * v[i][j][2] + v[i][j][3] * v[i][j][3]);
            const float rstd = rsqrtf(wave_sum(ss) * (1.f / 1024.f) + EPS);
#pragma unroll
            for (int j = 0; j < 4; ++j) { const f32x4 o = v[i][j] * rstd * sc[j] + sh[j]; u32x2 w; w.x = cvt_pk_bf16(o[0], o[1]); w.y = cvt_pk_bf16(o[2], o[3]);
                *(u32x2*)(A + (size_t)(row0 + i) * 1024 + 4 * lane + 256 * j) = w; } }
    }
}

constexpr int GCV = 264;
constexpr int KP = 136, TP = 72;
__device__ __forceinline__ f32x4 mma4f(float a, float b, f32x4 c) { return __builtin_amdgcn_mfma_f32_16x16x4f32(a, b, c, 0, 0, 0); }
template <int V> __device__ __forceinline__ void gdn_prep_phase(LAS unsigned char* lds) {
    const int tid = threadIdx.x, lane = tid & 63, wave = __builtin_amdgcn_readfirstlane(tid >> 6), n = lane & 15, q = lane >> 4;
    bf16_t* QKV = (bf16_t*)(KWS() + WS_QKV); const float* SM = (const float*)(KWS() + WS_SMALL);
    float* GC = (float*)(KWS() + ((V & 8) ? 472 * MiB : WS_GC)); bf16_t* TA = (V & 8) ? (bf16_t*)KOUT() : (bf16_t*)(KWS() + WS_TA);
    LAS bf16_t* Ks = (LAS bf16_t*)lds;
    LAS bf16_t* Qs = Ks + 64 * KP;
    LAS float* As = (LAS float*)lds;
    LAS float* KK = (LAS float*)(lds + 34816);
    LAS float* QK = KK + 64 * 68;
    LAS float* Tf = KK;
    LAS bf16_t* Ps = (LAS bf16_t*)(lds + 2 * 34816);
    LAS float* Rs = (LAS float*)(lds + 2 * 34816 + 36864);
    LAS float* gcs = Rs + 2 * 16 * 68;
    LAS float* bts = gcs + 128;
    LAS float* rks = bts + 128;
    LAS float* rqs = rks + 64;
    float gsave = 0.f, bsave = 0.f;
    const int row = tid >> 3, seg = tid & 7;
    u32x4 pq0, pq1, pk0, pk1; float pg = 0.f, pb = 0.f;
#define PREP_ISSUE(unit_) do { const int ci_ = (unit_) >> 3, h_ = (unit_) & 7, row0_ = chunk_row0(ci_); \
        const bf16_t* qp_ = QKV + (size_t)(row0_ + row) * QKV_LD + 128 * h_ + 16 * seg; pq0 = *(const u32x4*)qp_; pq1 = *(const u32x4*)(qp_ + 8); pk0 = *(const u32x4*)(qp_ + 1024); pk1 = *(const u32x4*)(qp_ + 1032); \
        if (wave < 2) { const int srow_ = row0_ + (wave ? 63 - lane : lane); pg = SM[(size_t)srow_ * SMALL_LD + 8 * wave + h_]; pb = SM[(size_t)srow_ * SMALL_LD + 16 + 8 * wave + h_]; } } while (0)
    int unit = blockIdx.x;
    if (unit < NCH * 8) PREP_ISSUE(unit);
    for (; unit < NCH * 8; unit += gridDim.x) {
        const int ci = unit >> 3, h = unit & 7, row0 = chunk_row0(ci);
        {
          float q0[8], q1[8], k0[8], k1[8]; unpack8(pq0, q0); unpack8(pq1, q1); unpack8(pk0, k0); unpack8(pk1, k1);
          float sq = 0.f, sk = 0.f;
#pragma unroll
          for (int e = 0; e < 8; ++e) { sq += q0[e] * q0[e] + q1[e] * q1[e]; sk += k0[e] * k0[e] + k1[e] * k1[e]; }
          sq += __shfl_xor(sq, 1); sq += __shfl_xor(sq, 2); sq += __shfl_xor(sq, 4);
          sk += __shfl_xor(sk, 1); sk += __shfl_xor(sk, 2); sk += __shfl_xor(sk, 4);
          const float rq = rsqrtf(sq + EPS) * 0.08838834764831845f, rk = rsqrtf(sk + EPS);
#pragma unroll
          for (int e = 0; e < 8; ++e) { q0[e] *= rq; q1[e] *= rq; k0[e] *= rk; k1[e] *= rk; }
          const u32x4 wq0 = pack8(q0), wq1 = pack8(q1), wk0 = pack8(k0), wk1 = pack8(k1);
          if (seg == 0) { rks[row] = rk; rqs[row] = rq; }
          *(LAS u32x4*)(Qs + row * KP + 16 * seg) = wq0; *(LAS u32x4*)(Qs + row * KP + 16 * seg + 8) = wq1;
          *(LAS u32x4*)(Ks + row * KP + 16 * seg) = wk0; *(LAS u32x4*)(Ks + row * KP + 16 * seg + 8) = wk1; }
        if (wave < 2) { const int d = wave; float g = pg;
            {
#define DPPZ(v_, ctrl_) __builtin_bit_cast(float, __builtin_amdgcn_update_dpp(0, __builtin_bit_cast(int, v_), ctrl_, 0xf, 0xf, false))
                g += DPPZ(g, 0x111); g += DPPZ(g, 0x112); g += DPPZ(g, 0x114); g += DPPZ(g, 0x118);
                const float t0 = __shfl(g, 15), t1 = __shfl(g, 31), t2 = __shfl(g, 47);
                g += (lane >= 16 ? t0 : 0.f) + (lane >= 32 ? t1 : 0.f) + (lane >= 48 ? t2 : 0.f);
#undef DPPZ
            }
            gcs[d * 64 + lane] = g; bts[d * 64 + lane] = pb; gsave = g; bsave = pb; }
        if (unit + (int)gridDim.x < NCH * 8) PREP_ISSUE(unit + gridDim.x);
        __syncthreads();
        if (wave < 2) { const int d = wave, pr = d ? 63 - lane : lane; const float g = gsave, gl = __shfl(g, 63), rkk = rks[pr], rqq = rqs[pr], eg = __expf(g);
            float* gv = GC + ((size_t)(ci * 8 + h) * 2 + d) * GCV; gv[lane] = eg * rkk; gv[64 + lane] = __expf(gl - g) * rkk; gv[128 + lane] = bsave; gv[192 + lane] = eg * rqq; if (lane == 63) gv[256] = eg; }
        if (!(V & 4)) for (int t = wave * 4; t < wave * 4 + 4; ++t) { const int which = t >> 4, mi = (t >> 2) & 3, ni = t & 3;
            const LAS bf16_t* Am = which ? Qs : Ks; f32x4 c = {0.f, 0.f, 0.f, 0.f};
#pragma unroll
            for (int ks = 0; ks < 4; ++ks) c = mma16(frag_std(Am, KP, 16 * mi, 32 * ks, lane), frag_std(Ks, KP, 16 * ni, 32 * ks, lane), c);
            LAS float* D = which ? QK : KK;
#pragma unroll
            for (int r = 0; r < 4; ++r) D[(16 * mi + 4 * q + r) * 68 + 16 * ni + n] = c[r]; }
        __syncthreads();
        { float av[2][8]; u32x4 at[2];
#pragma unroll
          for (int t = 0; t < 2; ++t) { const int item = tid + 512 * t, d = item >> 9, i = (item >> 3) & 63, j8 = item & 7; const int si = d ? 63 - i : i;
            if (V & 2) { for (int e = 0; e < 8; ++e) av[t][e] = 0.f; at[t] = (u32x4){0u, 0u, 0u, 0u}; continue; }
            float kk[8], qk[8], gj[8];
            { const int c0 = d ? 56 - 8 * j8 : 8 * j8; const f32x4 a0 = *(const LAS f32x4*)(KK + si * 68 + c0), a1 = *(const LAS f32x4*)(KK + si * 68 + c0 + 4), b0 = *(const LAS f32x4*)(QK + si * 68 + c0), b1 = *(const LAS f32x4*)(QK + si * 68 + c0 + 4);
              const f32x4 g0 = *(const LAS f32x4*)(gcs + d * 64 + 8 * j8), g1 = *(const LAS f32x4*)(gcs + d * 64 + 8 * j8 + 4);
#pragma unroll
              for (int e = 0; e < 4; ++e) { gj[e] = g0[e]; gj[4 + e] = g1[e];
                  if (d) { kk[e] = a1[3 - e]; kk[4 + e] = a0[3 - e]; qk[e] = b1[3 - e]; qk[4 + e] = b0[3 - e]; } else { kk[e] = a0[e]; kk[4 + e] = a1[e]; qk[e] = b0[e]; qk[4 + e] = b1[e]; } } }
            const float gi = gcs[d * 64 + i], bi = bts[d * 64 + i]; float tt[8];
#pragma unroll
            for (int e = 0; e < 8; ++e) { const int j = 8 * j8 + e; const float dec = (j <= i) ? __expf(gi - gj[e]) : 0.f;
                av[t][e] = (j < i) ? bi * kk[e] * dec : 0.f; tt[e] = qk[e] * dec; }
            at[t] = pack8(tt); }
          __syncthreads();
#pragma unroll
          for (int t = 0; t < 2; ++t) { const int item = tid + 512 * t, d = item >> 9, i = (item >> 3) & 63, j8 = item & 7;
            *(LAS f32x4*)(As + (d * 64 + i) * 68 + 8 * j8) = (f32x4){av[t][0], av[t][1], av[t][2], av[t][3]}; *(LAS f32x4*)(As + (d * 64 + i) * 68 + 8 * j8 + 4) = (f32x4){av[t][4], av[t][5], av[t][6], av[t][7]};
            *(LAS u32x4*)(Ps + ((2 * d + 1) * 64 + i) * TP + 8 * j8) = at[t]; } }
        __syncthreads();
        if (wave < 2 && !(V & 1)) { const int d = wave; const LAS float* Ad = As + d * 64 * 68; LAS float* Td = Tf + d * 64 * 68; LAS float* Rd = Rs + d * 16 * 68;
            {
                float t[16];
#pragma unroll
                for (int r = 0; r < 16; ++r) { float s0 = (r == n) ? 1.f : 0.f, s1 = 0.f;
#pragma unroll
                    for (int j = 0; j < r; ++j) { const float a = Ad[(16 * q + r) * 68 + 16 * q + j]; if (j & 1) s1 -= a * t[j]; else s0 -= a * t[j]; }
                    t[r] = s0 + s1; Td[(16 * q + r) * 68 + 16 * q + n] = t[r]; } }
            asm volatile("s_waitcnt lgkmcnt(0)" ::: "memory");
#pragma unroll
            for (int i = 1; i < 4; ++i) {
#pragma unroll
                for (int j = 0; j < i; ++j) { f32x4 c = {0.f, 0.f, 0.f, 0.f};
#pragma unroll
                    for (int k4 = 4 * j; k4 < 4 * i; ++k4) c = mma4f(Ad[(16 * i + n) * 68 + 4 * k4 + q], Td[(4 * k4 + q) * 68 + 16 * j + n], c);
#pragma unroll
                    for (int r = 0; r < 4; ++r) Rd[(4 * q + r) * 68 + 16 * j + n] = c[r]; }
                asm volatile("s_waitcnt lgkmcnt(0)" ::: "memory");
#pragma unroll
                for (int j = 0; j < i; ++j) { f32x4 c = {0.f, 0.f, 0.f, 0.f};
#pragma unroll
                    for (int k4 = 0; k4 < 4; ++k4) c = mma4f(Td[(16 * i + n) * 68 + 16 * i + 4 * k4 + q], Rd[(4 * k4 + q) * 68 + 16 * j + n], c);
#pragma unroll
                    for (int r = 0; r < 4; ++r) Td[(16 * i + 4 * q + r) * 68 + 16 * j + n] = -c[r]; }
                asm volatile("s_waitcnt lgkmcnt(0)" ::: "memory");
            } }
        __syncthreads();
#pragma unroll
        for (int t = 0; t < 2; ++t) { const int item = tid + 512 * t, d = item >> 9, i = (item >> 3) & 63, j8 = item & 7; float tt[8];
            const f32x4 a0 = *(const LAS f32x4*)(Tf + (d * 64 + i) * 68 + 8 * j8), a1 = *(const LAS f32x4*)(Tf + (d * 64 + i) * 68 + 8 * j8 + 4);
#pragma unroll
            for (int e = 0; e < 8; ++e) { const int j = 8 * j8 + e; const float v = e < 4 ? a0[e & 3] : a1[e & 3]; tt[e] = (j < i) ? v : (j == i ? 1.f : 0.f); }
            *(LAS u32x4*)(Ps + ((2 * d) * 64 + i) * TP + 8 * j8) = pack8(tt); }
        __syncthreads();
        for (int e = tid; e < 2048; e += 512) { const int dm = e >> 9, i = (e >> 3) & 63, c8 = e & 7;
            *(u32x4*)(TA + ((((size_t)(ci * 8 + h) * 4 + dm) * 4096 + i * 64 + 8 * c8) & ((V & 8) ? (size_t)0x3ffffff : ~(size_t)0))) = *(const LAS u32x4*)(Ps + (dm * 64 + i) * TP + 8 * c8); }
        __syncthreads();
    }
#undef PREP_ISSUE
}

typedef short v4i16_t __attribute__((ext_vector_type(4)));
__device__ __forceinline__ bf16x4 tr4(const LAS bf16_t* p) { return __builtin_bit_cast(bf16x4, __builtin_amdgcn_ds_read_tr16_b64_v4i16((LAS v4i16_t*)p)); }
__device__ __forceinline__ bf16x8 frag_tr_perm(const LAS bf16_t* X, int pitch, int r0, int c0, int lane) {
    const int i = lane & 15, q = lane >> 4; const LAS bf16_t* p = X + (r0 + 4 * q + (i >> 2)) * pitch + c0 + 4 * (i & 3);
    const bf16x4 a = tr4(p), b = tr4(p + 16 * pitch); return (bf16x8){a[0], a[1], a[2], a[3], b[0], b[1], b[2], b[3]};
}
__device__ __forceinline__ bf16x8 frag_tr_std(const LAS bf16_t* X, int pitch, int r0, int c0, int lane) {
    const int i = lane & 15, q = lane >> 4; const LAS bf16_t* p = X + (r0 + 8 * q + (i >> 2)) * pitch + c0 + 4 * (i & 3);
    const bf16x4 a = tr4(p), b = tr4(p + 4 * pitch); return (bf16x8){a[0], a[1], a[2], a[3], b[0], b[1], b[2], b[3]};
}
__device__ __forceinline__ int Pmap(int t, int i) { return 32 * (t >> 1) + 8 * (i >> 2) + 4 * (t & 1) + (i & 3); }
__device__ __forceinline__ bf16x8 frag_rowP(const LAS bf16_t* X, int pitch, int t, int c0, int lane) {
    return *(const LAS bf16x8*)(X + Pmap(t, lane & 15) * pitch + c0 + 8 * (lane >> 4));
}
__device__ __forceinline__ bf16x8 frag_trP(const LAS bf16_t* X, int pitch, int r0, int t, int lane) {
    const int i = lane & 15, q = lane >> 4; const LAS bf16_t* p = X + (r0 + 8 * q + (i >> 2)) * pitch + 32 * (t >> 1) + 8 * (i & 3) + 4 * (t & 1);
    const bf16x4 a = tr4(p), b = tr4(p + 4 * pitch); return (bf16x8){a[0], a[1], a[2], a[3], b[0], b[1], b[2], b[3]};
}
__device__ __forceinline__ u32x2 pack4(f32x4 v) { u32x2 w; w.x = cvt_pk_bf16(v[0], v[1]); w.y = cvt_pk_bf16(v[2], v[3]); return w; }
__device__ __forceinline__ f32x4 unpack4(u32x2 w) { return (f32x4){bflo(w.x), bfhi(w.x), bflo(w.y), bfhi(w.y)}; }
__device__ __forceinline__ f32x4 bf4f(bf16x4 v) { return (f32x4){bf2f((bf16_t)v[0]), bf2f((bf16_t)v[1]), bf2f((bf16_t)v[2]), bf2f((bf16_t)v[3])}; }


#define SBAR __builtin_amdgcn_sched_barrier(0);
#define WG_BARRIER() do { asm volatile("s_waitcnt lgkmcnt(0)" ::: "memory"); __builtin_amdgcn_s_barrier(); asm volatile("" ::: "memory"); } while (0)
struct CtxOrder { int c, n;
    __device__ __forceinline__ bool next(int i, pg8::Unit& u) const { const int L = i * n + c; if (L >= 4 * (N1B / 256)) return false; u.pm = M_LAT / 256 + L / (N1B / 256); u.pn = L % (N1B / 256); return true; }
    __device__ __forceinline__ void a_ready(const pg8::Unit&) const {}
    __device__ __forceinline__ void done(const pg8::Unit&) const {}
};
template <int V> __device__ __forceinline__ void gdn_scan_phase(LAS unsigned char* lds) {
    if (blockIdx.x >= NB * 8 * 2 * 2) {
        if (V == 0) {
            const int ci_ = (int)blockIdx.x - NB * 8 * 2 * 2, ni_ = (int)gridDim.x - NB * 8 * 2 * 2;
            {
                unsigned char* ws = KWS();
                pg8::Gemm g{(const bf16_t*)(ws + WS_A), (const bf16_t*)(ws + WS_W1B), M_ALL, N1B, 1024}; CtxOrder S{ci_, ni_};
                EpiConv E{(bf16_t*)(ws + WS_XCT) - (size_t)M_LAT * XBC_LD, XBC_LD, KIN(I_SCW), KIN(I_SCB), 12, nullptr, nullptr, (LAS float*)(lds + XL_OFF)};
                pg8::gemm_phase<EpiConv, CtxOrder, true, true>(lds, g, S, E); }
            __syncthreads();
            weight_convert(lds, N_ITEMS_W1B_END, N_ITEMS_ALL, ci_ * 8 + (threadIdx.x >> 6), ni_ * 8);
        }
        return; }
    const int tid = threadIdx.x, lane = tid & 63, wave = __builtin_amdgcn_readfirstlane(tid >> 6), n = lane & 15, q = lane >> 4;
    const int unit = (blockIdx.x & 7) * 8 + ((blockIdx.x >> 3) >> 1), half = (blockIdx.x >> 3) & 1;
    const int b = unit >> 4, h = (unit >> 1) & 7, d = unit & 1, dvl = 16 * (wave & 3), dv0 = 64 * half + dvl;
    constexpr int BUFB = 2 * 64 * 128 * 2 + 3 * 64 * 64 * 2 + 1280;
#define GSW_K(r_) ((((r_) & 3) << 2) ^ ((((r_) >> 3) & 1) * 3) ^ ((((r_) >> 4) & 1) * 2))
#define GSW_Q(r_) ((r_) & 15)
#define GSW_V(r_) (((((r_) >> 1) & 1) << 1) | ((((r_) >> 3) & 1) << 2))
#define GSW_T(r_) ((((r_) >> 1) & 1) | ((((r_) >> 3) & 1) << 1) | ((((r_) >> 4) & 1) << 2))
#define GSW_A(r_) (((r_) >> 1) & 7)
#define GDN_CHUNK(s_, ci_, row0_) do { if ((s_) < 4) { const int cc_ = d ? 3 - (s_) : (s_); ci_ = NCH_LAT + 4 * b + cc_; row0_ = M_LAT + CTXL * b + 64 * cc_; } \
        else { const int cc_ = d ? 127 - ((s_) - 4) : ((s_) - 4); ci_ = 128 * b + cc_; row0_ = SEQ * b + 64 * cc_; } } while (0)
    if (wave >= 4) {
        const int lt = tid & 127, pair = (wave - 4) >> 1;
        const auto rQ = __builtin_amdgcn_make_buffer_rsrc((void*)(KWS() + WS_QKV), (short)0, (int)((size_t)M_ALL * QKV_LD * 2), 0x00020000);
        const auto rT = __builtin_amdgcn_make_buffer_rsrc((void*)(KWS() + WS_TA), (short)0, (int)((size_t)NCH * 8 * 4 * 4096 * 2), 0x00020000);
        const auto rG = __builtin_amdgcn_make_buffer_rsrc((void*)(KWS() + WS_GC), (short)0, (int)((size_t)NCH * 8 * 2 * GCV * 4), 0x00020000);
        const int vqk = ((d ? 7 - (lt >> 4) : (lt >> 4)) * QKV_LD + 8 * (lt & 15)) * 2, vv_ = ((d ? 15 - (lt >> 3) : (lt >> 3)) * QKV_LD + 8 * (lt & 7)) * 2;
        const int vt = ((lt >> 3) * 64 + 8 * (lt & 7)) * 2, vg0 = lt * 4, vg1 = (128 + lt) * 4, vg2 = (256 + (lt & 3)) * 4;
        u32x4 rq[8], rk[8], rv[4], rt[4], ra[4]; float rc0 = 0.f, rc1 = 0.f, rc2 = 0.f;
        LAS bf16_t* Kw = (LAS bf16_t*)(lds + (1 - pair) * BUFB);
#define BL128(r_, v_, s_) __builtin_bit_cast(u32x4, __builtin_amdgcn_raw_buffer_load_b128(r_, v_, s_, 0))
#define GDN_ISSUE(s_) do { int ci_, row0_; GDN_CHUNK(s_, ci_, row0_); \
            _Pragma("unroll") for (int i_ = 0; i_ < 8; ++i_) { const int so_ = ((row0_ + (d ? 56 - 8 * i_ : 8 * i_)) * QKV_LD + 128 * h) * 2; rq[i_] = BL128(rQ, vqk, so_); rk[i_] = BL128(rQ, vqk, so_ + 2048); } \
            _Pragma("unroll") for (int i_ = 0; i_ < 4; ++i_) { const int so_ = ((row0_ + (d ? 48 - 16 * i_ : 16 * i_)) * QKV_LD + 2048 + 128 * h + 64 * half) * 2; rv[i_] = BL128(rQ, vv_, so_); \
                const int st_ = (((ci_ * 8 + h) * 4 + 2 * d) * 4096 + 16 * i_ * 64) * 2; rt[i_] = BL128(rT, vt, st_); ra[i_] = BL128(rT, vt, st_ + 8192); } \
            { const int sg_ = ((ci_ * 8 + h) * 2 + d) * GCV * 4; rc0 = __builtin_bit_cast(float, __builtin_amdgcn_raw_buffer_load_b32(rG, vg0, sg_, 0)); rc1 = __builtin_bit_cast(float, __builtin_amdgcn_raw_buffer_load_b32(rG, vg1, sg_, 0)); rc2 = __builtin_bit_cast(float, __builtin_amdgcn_raw_buffer_load_b32(rG, vg2, sg_, 0)); } } while (0)
#define GDN_WRITE() do { \
            _Pragma("unroll") for (int i_ = 0; i_ < 8; ++i_) { const int p_ = lt + 128 * i_, pos_ = p_ >> 4, c16_ = p_ & 15; \
                *(LAS u32x4*)(Kw + pos_ * 128 + 8 * (c16_ ^ GSW_K(pos_))) = rk[i_]; *(LAS u32x4*)(Kw + 64 * 128 + pos_ * 128 + 8 * (c16_ ^ GSW_Q(pos_))) = rq[i_]; } \
            _Pragma("unroll") for (int i_ = 0; i_ < 4; ++i_) { const int p_ = lt + 128 * i_, pos_ = p_ >> 3, c8_ = p_ & 7; \
                *(LAS u32x4*)(Kw + 128 * 128 + pos_ * 64 + 8 * (c8_ ^ GSW_V(pos_))) = rv[i_]; *(LAS u32x4*)(Kw + 128 * 128 + 64 * 64 + pos_ * 64 + 8 * (c8_ ^ GSW_T(pos_))) = rt[i_]; \
                *(LAS u32x4*)(Kw + 128 * 128 + 128 * 64 + pos_ * 64 + 8 * (c8_ ^ GSW_A(pos_))) = ra[i_]; } \
            { LAS float* v_ = (LAS float*)(Kw + 128 * 128 + 192 * 64); v_[lt] = rc0; v_[128 + lt] = rc1; if (lt < 4) v_[256 + lt] = rc2; } } while (0)
        if (V & 1) { for (int s = 0; s < 133; ++s) WG_BARRIER(); return; }
        if (pair == 1) { GDN_ISSUE(0); GDN_WRITE(); GDN_ISSUE(2); } else { GDN_ISSUE(1); }
        WG_BARRIER();
        for (int s = 0; s < 132; s += 2) {
            if (pair == 0) { GDN_WRITE(); if (s + 3 < 132) GDN_ISSUE(s + 3); }
            WG_BARRIER();
            if (pair == 1 && s + 2 < 132) { GDN_WRITE(); if (s + 4 < 132) GDN_ISSUE(s + 4); }
            WG_BARRIER();
        }
#undef GDN_ISSUE
#undef GDN_WRITE
#undef BL128
        return;
    }
    bf16_t* O = (V & 8) ? (bf16_t*)(KWS() + 472 * MiB) : (bf16_t*)KOUT() + (size_t)d * M_LAT * 1024;
    const auto rO = __builtin_amdgcn_make_buffer_rsrc((void*)O, (short)0, (int)((size_t)M_LAT * 1024 * 2), 0x00020000);
    if (V & 2) { for (int s = 0; s < 133; ++s) WG_BARRIER(); return; }
    f32x4 S[8];
#pragma unroll
    for (int i = 0; i < 8; ++i) S[i] = (f32x4){0.f, 0.f, 0.f, 0.f};
    WG_BARRIER();
    for (int s = 0; s < 132; ++s) {
        const bool latent = s >= 4; int ci, row0; GDN_CHUNK(s, ci, row0); (void)ci;
        const LAS bf16_t* Kp = (const LAS bf16_t*)(lds + (s & 1) * BUFB); const LAS bf16_t* Qp = Kp + 64 * 128; const LAS bf16_t* Vp = Qp + 64 * 128;
        const LAS bf16_t* Tp = Vp + 64 * 64; const LAS bf16_t* Ap = Tp + 64 * 64; const LAS float* vec = (const LAS float*)(Ap + 64 * 64);
        const int rP = 8 * (n >> 2) + (n & 3);
        const int gkP = ((n & 3) << 2) ^ (((n >> 2) & 1) * 3) ^ ((n >> 3) * 2);
        const int rX = 8 * q + (n >> 2), gkX = ((n >> 2) << 2) ^ ((q & 1) * 3) ^ ((q >> 1) * 2);
#define RD_KF(mi_, ks_) (*(const LAS bf16x8*)(Kp + (rP + 32 * ((mi_) >> 1) + 4 * ((mi_) & 1)) * 128 + 8 * ((4 * (ks_) + q) ^ gkP)))
#define RD_TF(mi_, ks_) (*(const LAS bf16x8*)(Tp + (rP + 32 * ((mi_) >> 1) + 4 * ((mi_) & 1)) * 64 + 8 * ((4 * (ks_) + q) ^ (n >> 1))))
#define RD_QF(ni_, ks_) (*(const LAS bf16x8*)(Qp + (16 * (ni_) + n) * 128 + 8 * ((4 * (ks_) + q) ^ n)))
#define RD_AF(ni_, ks_) (*(const LAS bf16x8*)(Ap + (16 * (ni_) + n) * 64 + 8 * ((4 * (ks_) + q) ^ (n >> 1))))
        bf16x8 Sb[4];
#pragma unroll
        for (int ks = 0; ks < 4; ++ks) Sb[ks] = acc_frag(S[2 * ks], S[2 * ks + 1]);
#define ILV(nm_, nd_) __builtin_amdgcn_sched_group_barrier(0x008, nm_, 0); __builtin_amdgcn_sched_group_barrier(0x100, nd_, 0);
        f32x4 kS[4]; bf16x8 kf[4][4];
#pragma unroll
        for (int ks = 0; ks < 4; ++ks)
#pragma unroll
            for (int mi = 0; mi < 4; ++mi) kf[mi][ks] = RD_KF(mi, ks);
#pragma unroll
        for (int mi = 0; mi < 4; ++mi) kS[mi] = (f32x4){0.f, 0.f, 0.f, 0.f};
        SBAR
#pragma unroll
        for (int ks = 0; ks < 4; ++ks)
#pragma unroll
            for (int mi = 0; mi < 4; ++mi) kS[mi] = mma16(kf[mi][ks], Sb[ks], kS[mi]);
        bf16x8 tf[4][2]; f32x4 eg[4], bt[4], vv[4];
#pragma unroll
        for (int mi = 0; mi < 4; ++mi) { const int p0 = 32 * (mi >> 1) + 8 * q + 4 * (mi & 1);
            eg[mi] = *(const LAS f32x4*)(vec + p0); bt[mi] = *(const LAS f32x4*)(vec + 128 + p0);
            vv[mi] = bf4f(tr4(Vp + (p0 + (n >> 2)) * 64 + 8 * ((2 * (wave & 3) + ((n & 3) >> 1)) ^ ((((n >> 3) & 1) << 1) | ((q & 1) << 2))) + 4 * (n & 1))); }
#pragma unroll
        for (int ks = 0; ks < 2; ++ks)
#pragma unroll
            for (int mi = 0; mi < 4; ++mi) tf[mi][ks] = RD_TF(mi, ks);
        ILV(1, 2) ILV(1, 2) ILV(1, 2) ILV(1, 2) ILV(1, 1) ILV(1, 1) ILV(1, 1) ILV(1, 1) ILV(1, 1) ILV(1, 1) ILV(1, 1) ILV(1, 1) ILV(1, 1) ILV(1, 1) ILV(1, 1) ILV(1, 1)
        SBAR
        f32x4 rr[4];
#pragma unroll
        for (int mi = 0; mi < 4; ++mi) rr[mi] = bt[mi] * (vv[mi] - eg[mi] * kS[mi]);
        const bf16x8 rb[2] = {acc_frag(rr[0], rr[1]), acc_frag(rr[2], rr[3])};
        f32x4 vn[4];
#pragma unroll
        for (int mi = 0; mi < 4; ++mi) vn[mi] = (f32x4){0.f, 0.f, 0.f, 0.f};
#pragma unroll
        for (int ks = 0; ks < 2; ++ks)
#pragma unroll
            for (int mi = 0; mi < 4; ++mi) vn[mi] = mma16(tf[mi][ks], rb[ks], vn[mi]);
        bf16x8 ktr[8][2]; f32x4 ed[4];
#pragma unroll
        for (int mi = 0; mi < 4; ++mi) ed[mi] = *(const LAS f32x4*)(vec + 64 + 32 * (mi >> 1) + 8 * q + 4 * (mi & 1));
        const float egl = vec[256];
#pragma unroll
        for (int ks = 0; ks < 2; ++ks)
#pragma unroll
            for (int mt = 0; mt < 8; ++mt) { const LAS bf16_t* p = Kp + (32 * ks + rX) * 128 + 8 * ((4 * (mt >> 1) + (n & 3)) ^ gkX) + 4 * (mt & 1);
                const bf16x4 a = tr4(p), b = tr4(p + 4 * 128); ktr[mt][ks] = (bf16x8){a[0], a[1], a[2], a[3], b[0], b[1], b[2], b[3]}; }
        ILV(1, 5) ILV(1, 5) ILV(1, 5) ILV(1, 5) ILV(1, 5) ILV(1, 5) ILV(1, 5) ILV(1, 5)
        SBAR
        f32x4 vp[4];
#pragma unroll
        for (int mi = 0; mi < 4; ++mi) vp[mi] = vn[mi] * ed[mi];
        const bf16x8 vpb[2] = {acc_frag(vp[0], vp[1]), acc_frag(vp[2], vp[3])};
#pragma unroll
        for (int mt = 0; mt < 8; ++mt) S[mt] = S[mt] * egl;
#pragma unroll
        for (int ks = 0; ks < 2; ++ks)
#pragma unroll
            for (int mt = 0; mt < 8; ++mt) S[mt] = mma16(ktr[mt][ks], vpb[ks], S[mt]);
        f32x4 qT[4], oT[4]; float ev[4]; bf16x8 qf[4][4];
#pragma unroll
        for (int ks = 0; ks < 4; ++ks)
#pragma unroll
            for (int ni = 0; ni < 4; ++ni) qf[ni][ks] = RD_QF(ni, ks);
#pragma unroll
        for (int ni = 0; ni < 4; ++ni) ev[ni] = vec[192 + 16 * ni + n];
        ILV(1, 2) ILV(1, 2) ILV(1, 2) ILV(1, 2) ILV(1, 1) ILV(1, 1) ILV(1, 1) ILV(1, 1) ILV(1, 1) ILV(1, 1) ILV(1, 1) ILV(1, 1) ILV(1, 1) ILV(1, 1) ILV(1, 1) ILV(1, 1)
        SBAR
#pragma unroll
        for (int ni = 0; ni < 4; ++ni) { qT[ni] = (f32x4){0.f, 0.f, 0.f, 0.f}; oT[ni] = (f32x4){0.f, 0.f, 0.f, 0.f}; }
#pragma unroll
        for (int ks = 0; ks < 4; ++ks)
#pragma unroll
            for (int ni = 0; ni < 4; ++ni) qT[ni] = mma16(Sb[ks], qf[ni][ks], qT[ni]);
        const bf16x8 vb[2] = {acc_frag(vn[0], vn[1]), acc_frag(vn[2], vn[3])};
        bf16x8 af[4][2];
#pragma unroll
        for (int ks = 0; ks < 2; ++ks)
#pragma unroll
            for (int ni = 0; ni < 4; ++ni) af[ni][ks] = RD_AF(ni, ks);
        ILV(2, 1) ILV(2, 1) ILV(2, 1) ILV(2, 1) ILV(2, 1) ILV(2, 1) ILV(2, 1) ILV(2, 1)
        SBAR
#pragma unroll
        for (int ks = 0; ks < 2; ++ks)
#pragma unroll
            for (int ni = 0; ni < 4; ++ni) oT[ni] = mma16(vb[ks], af[ni][ks], oT[ni]);
        SBAR
        if (latent) {
#pragma unroll
            for (int p = 0; p < 2; ++p) {
                const f32x4 A = oT[2 * p] + qT[2 * p] * ev[2 * p], B = oT[2 * p + 1] + qT[2 * p + 1] * ev[2 * p + 1]; float o[8];
#pragma unroll
                for (int e = 0; e < 4; ++e) { const float ae = A[e], be = B[e];
                    const auto r = __builtin_amdgcn_permlane16_swap(__float_as_uint(ae), __float_as_uint(be), false, false);
                    o[e] = __uint_as_float(r[0]); o[4 + e] = __uint_as_float(r[1]); }
                const int pos = 16 * (2 * p + (q & 1)) + n;
                if (V & 8) { const size_t orow = (size_t)row0 + (d ? 63 - pos : pos); *(u32x4*)(O + ((orow * 1024 + 128 * h + dv0 + 8 * (q >> 1)) & 0xffffff)) = pack8(o); }
                else __builtin_amdgcn_raw_buffer_store_b128(__builtin_bit_cast(decltype(__builtin_amdgcn_raw_buffer_load_b128(rO, 0, 0, 0)), pack8(o)), rO, ((d ? 63 - pos : pos) * 1024 + 128 * h + dv0 + 8 * (q >> 1)) * 2, row0 * 2048, 0); }
        }
#undef ILV
        SBAR
        WG_BARRIER();
    }
#undef GDN_CHUNK
#undef RD_KF
#undef RD_TF
#undef RD_QF
#undef RD_AF
}

constexpr int XP8 = 520;
__device__ __forceinline__ void ssd_diag_phase(LAS unsigned char* lds) {
    const int tid = threadIdx.x, lane = tid & 63, wave = tid >> 6, n = lane & 15, q = lane >> 4;
    const bf16_t* XBC = (const bf16_t*)(KWS() + WS_XBC); const float* SM = (const float*)(KWS() + WS_SMALL); bf16_t* Y = (bf16_t*)(KWS() + WS_Y);
    LAS bf16_t* Cp = (LAS bf16_t*)lds;
    LAS bf16_t* Bp = Cp + 64 * KP;
    LAS bf16_t* Xp = Bp + 64 * KP;
    LAS float* CBs = (LAS float*)(Xp + 64 * XP8);
    LAS float* vecs = CBs + 64 * 68;
    u32x4 pb[2], pc[2], px[8]; float pdf = 0.f, pdb = 0.f;
#define DIAG_ISSUE(unit_) do { const int ci_ = (unit_) >> 2, grp_ = (unit_) & 3, row0_ = ci_ * 64, hh_ = 8 * grp_ + wave; \
        _Pragma("unroll") for (int i_ = 0; i_ < 2; ++i_) { const int pc_ = tid + 512 * i_, pos_ = pc_ >> 4, c16_ = pc_ & 15; const bf16_t* g_ = XBC + (size_t)(row0_ + pos_) * XBC_LD + 2048 + 128 * grp_ + 8 * c16_; pb[i_] = *(const u32x4*)g_; pc[i_] = *(const u32x4*)(g_ + 512); } \
        _Pragma("unroll") for (int i_ = 0; i_ < 8; ++i_) { const int pc_ = tid + 512 * i_, pos_ = pc_ >> 6, c64_ = pc_ & 63; px[i_] = *(const u32x4*)(XBC + (size_t)(row0_ + pos_) * XBC_LD + 512 * grp_ + 8 * c64_); } \
        pdf = SM[(size_t)(row0_ + lane) * SMALL_LD + 32 + hh_]; pdb = SM[(size_t)(row0_ + lane) * SMALL_LD + 64 + hh_]; } while (0)
    int unit = blockIdx.x;
    if (unit < NCH_LAT * 4) DIAG_ISSUE(unit);
    for (; unit < NCH_LAT * 4; unit += gridDim.x) {
        const int ci = unit >> 2, grp = unit & 3, row0 = ci * 64, hh = 8 * grp + wave;
        __syncthreads();
#pragma unroll
        for (int i = 0; i < 2; ++i) { const int pc_ = tid + 512 * i, pos = pc_ >> 4, c16 = pc_ & 15; *(LAS u32x4*)(Bp + pos * KP + 8 * c16) = pb[i]; *(LAS u32x4*)(Cp + pos * KP + 8 * c16) = pc[i]; }
#pragma unroll
        for (int i = 0; i < 8; ++i) { const int pc_ = tid + 512 * i, pos = pc_ >> 6, c64 = pc_ & 63; *(LAS u32x4*)(Xp + pos * XP8 + 8 * c64) = px[i]; }
        {
            const float a_f = -expf(KIN(I_SALOG)[hh]), a_b = -expf(KIN(I_SALOG)[32 + hh]);
            const float dtf = pdf, dtb = pdb;
            float af = dtf * a_f, ab = dtb * a_b;
            {
#define DPPZ(v_, ctrl_) __builtin_bit_cast(float, __builtin_amdgcn_update_dpp(0, __builtin_bit_cast(int, v_), ctrl_, 0xf, 0xf, false))
              af += DPPZ(af, 0x111); af += DPPZ(af, 0x112); af += DPPZ(af, 0x114); af += DPPZ(af, 0x118);
              ab += DPPZ(ab, 0x101); ab += DPPZ(ab, 0x102); ab += DPPZ(ab, 0x104); ab += DPPZ(ab, 0x108);
              const float f0 = __shfl(af, 15), f1 = __shfl(af, 31), f2 = __shfl(af, 47), b1 = __shfl(ab, 16), b2 = __shfl(ab, 32), b3 = __shfl(ab, 48);
              af += (lane >= 16 ? f0 : 0.f) + (lane >= 32 ? f1 : 0.f) + (lane >= 48 ? f2 : 0.f);
              ab += (lane < 48 ? b3 : 0.f) + (lane < 32 ? b2 : 0.f) + (lane < 16 ? b1 : 0.f);
#undef DPPZ
            }
            LAS float* v = vecs + wave * 256; v[lane] = af; v[64 + lane] = ab; v[128 + lane] = dtf; v[192 + lane] = dtb; }
        if (unit + (int)gridDim.x < NCH_LAT * 4) DIAG_ISSUE(unit + gridDim.x);
        __syncthreads();
        for (int t = wave * 2; t < wave * 2 + 2; ++t) { const int mi = t >> 2, ni = t & 3; f32x4 c = (f32x4){0.f, 0.f, 0.f, 0.f};
#pragma unroll
            for (int ks = 0; ks < 4; ++ks) c = mma16(frag_std(Cp, KP, 16 * mi, 32 * ks, lane), frag_std(Bp, KP, 16 * ni, 32 * ks, lane), c);
#pragma unroll
            for (int r = 0; r < 4; ++r) CBs[(16 * mi + 4 * q + r) * 68 + 16 * ni + n] = c[r]; }
        __syncthreads();
        const LAS float* v = vecs + wave * 256; const float Dh = KIN(I_SD)[hh];
        bf16x8 xa[4][2];
#pragma unroll
        for (int pt = 0; pt < 4; ++pt)
#pragma unroll
            for (int ks = 0; ks < 2; ++ks) xa[pt][ks] = frag_tr_std(Xp, XP8, 32 * ks, 64 * wave + 16 * pt, lane);
#pragma unroll
        for (int mi = 0; mi < 4; ++mi) {
            const int i = 16 * mi + n; const float af_i = v[i], ab_i = v[64 + i], dd_i = v[128 + i] + v[192 + i];
            f32x4 yT[4];
#pragma unroll
            for (int pt = 0; pt < 4; ++pt) yT[pt] = (f32x4){0.f, 0.f, 0.f, 0.f};
#pragma unroll
            for (int ks = 0; ks < 2; ++ks) { const int j0 = 32 * ks + 8 * q; float m[8];
#pragma unroll
                for (int hf = 0; hf < 2; ++hf) { const f32x4 cb = *(const LAS f32x4*)(CBs + i * 68 + j0 + 4 * hf), afj = *(const LAS f32x4*)(v + j0 + 4 * hf), abj = *(const LAS f32x4*)(v + 64 + j0 + 4 * hf),
                        dfj = *(const LAS f32x4*)(v + 128 + j0 + 4 * hf), dbj = *(const LAS f32x4*)(v + 192 + j0 + 4 * hf);
#pragma unroll
                    for (int e = 0; e < 4; ++e) { const int j = j0 + 4 * hf + e;
                        const bool all_lo = 32 * ks + 31 < 16 * mi, all_hi = 32 * ks > 16 * mi + 15;
                        const bool lo = all_lo ? true : (all_hi ? false : (j < i)), dg = (all_lo || all_hi) ? false : (j == i);
                        const float arg = lo ? (af_i - afj[e]) : (ab_i - abj[e]); const float w = lo ? dfj[e] : dbj[e];
                        m[4 * hf + e] = cb[e] * (dg ? dd_i : __expf(arg) * w); } }
                const bf16x8 Mb = __builtin_bit_cast(bf16x8, pack8(m));
#pragma unroll
                for (int pt = 0; pt < 4; ++pt) yT[pt] = mma16(xa[pt][ks], Mb, yT[pt]); }
#pragma unroll
            for (int p = 0; p < 2; ++p) {
                const f32x4 A = yT[2 * p] + unpack4(*(const LAS u32x2*)(Xp + i * XP8 + 64 * wave + 16 * (2 * p) + 4 * q)) * Dh, B = yT[2 * p + 1] + unpack4(*(const LAS u32x2*)(Xp + i * XP8 + 64 * wave + 16 * (2 * p + 1) + 4 * q)) * Dh; float o[8];
#pragma unroll
                for (int e = 0; e < 4; ++e) { const float ae = A[e], be = B[e];
                    const auto r = __builtin_amdgcn_permlane16_swap(__float_as_uint(ae), __float_as_uint(be), false, false);
                    o[e] = __uint_as_float(r[0]); o[4 + e] = __uint_as_float(r[1]); }
                *(u32x4*)(Y + (size_t)(row0 + i) * 2048 + 64 * hh + 16 * (2 * p + (q & 1)) + 8 * (q >> 1)) = pack8(o); }
        }
    }
#undef DIAG_ISSUE
}

constexpr int XH = 40;
template <int V> __device__ __forceinline__ void ssd_scan_phase(LAS unsigned char* lds) {
    if (blockIdx.x >= NB * 32 * 2) return;
    const int tid = threadIdx.x, lane = tid & 63, wave = __builtin_amdgcn_readfirstlane(tid >> 6), n = lane & 15, q = lane >> 4;
    const int pr = (blockIdx.x & 7) * 2 + ((blockIdx.x >> 3) >> 4), wi = (blockIdx.x >> 3) & 15;
    const int b = pr >> 2, grp = pr & 3, hh = 8 * grp + (wi >> 1), ph = wi & 1;
    constexpr int DIRB = (2 * 64 * 128 + 64 * XH) * 2 + 512, BUFB = 2 * DIRB;
#define SSD_ROW0(s_, dd_) (((s_) < 4) ? (M_LAT + CTXL * b + 64 * ((dd_) ? 3 - (s_) : (s_))) : (SEQ * b + 64 * ((dd_) ? 127 - ((s_) - 4) : ((s_) - 4))))
    if (wave >= 4) {
        const int pair = (wave - 4) >> 1, sdd = (wave - 4) & 1;
        const auto rX = __builtin_amdgcn_make_buffer_rsrc((void*)(KWS() + WS_XBC), (short)0, (int)((size_t)M_ALL * XBC_LD * 2), 0x00020000);
        const auto rS = __builtin_amdgcn_make_buffer_rsrc((void*)(KWS() + WS_SMALL), (short)0, (int)((size_t)M_ALL * SMALL_LD * 4), 0x00020000);
        const float a_sd = -expf(KIN(I_SALOG)[sdd * 32 + hh]);
        const int vcb = ((sdd ? 3 - (lane >> 4) : (lane >> 4)) * XBC_LD + 8 * (lane & 15)) * 2, vx = ((sdd ? 15 - (lane >> 2) : (lane >> 2)) * XBC_LD + 8 * (lane & 3)) * 2, vd = (sdd ? 63 - lane : lane) * SMALL_LD * 4;
        u32x4 rc[16], rb[16], rx[4]; float rdt = 0.f;
        LAS bf16_t* Cs = (LAS bf16_t*)(lds + (1 - pair) * BUFB + sdd * DIRB);
#define BL128(r_, v_, s_) __builtin_bit_cast(u32x4, __builtin_amdgcn_raw_buffer_load_b128(r_, v_, s_, 0))
#define SSD_ISSUE_CB(s_) do { const int row0_ = SSD_ROW0(s_, sdd); \
            _Pragma("unroll") for (int i_ = 0; i_ < 16; ++i_) { const int so_ = ((row0_ + (sdd ? 60 - 4 * i_ : 4 * i_)) * XBC_LD + 2048 + 128 * grp) * 2; rb[i_] = BL128(rX, vcb, so_); rc[i_] = BL128(rX, vcb, so_ + 1024); } } while (0)
#define SSD_ISSUE_X(s_) do { const int row0_ = SSD_ROW0(s_, sdd); \
            _Pragma("unroll") for (int i_ = 0; i_ < 4; ++i_) { const int so_ = ((row0_ + (sdd ? 48 - 16 * i_ : 16 * i_)) * XBC_LD + 64 * hh + 32 * ph) * 2; rx[i_] = __builtin_bit_cast(u32x4, __builtin_amdgcn_raw_buffer_load_b128(rX, vx, so_, 2)); }   \
            rdt = __builtin_bit_cast(float, __builtin_amdgcn_raw_buffer_load_b32(rS, vd, (row0_ * SMALL_LD + 32 + 32 * sdd + hh) * 4, 0)); } while (0)
#define SSD_WRITE_CB() do { \
            _Pragma("unroll") for (int i_ = 0; i_ < 16; ++i_) { const int pc_ = lane + 64 * i_, pos_ = pc_ >> 4, c16_ = pc_ & 15; *(LAS u32x4*)(Cs + pos_ * 128 + 8 * (c16_ ^ (pos_ & 15))) = rc[i_]; *(LAS u32x4*)(Cs + 64 * 128 + pos_ * 128 + 8 * (c16_ ^ ((pos_ & 3) << 2))) = rb[i_]; } } while (0)
#define SSD_WRITE_X() do { \
            { LAS float* eas_ = (LAS float*)(Cs + 128 * 128 + 64 * XH); float ac_ = rdt * a_sd; \
                  \
                ac_ += DPP0(ac_, 0x111); ac_ += DPP0(ac_, 0x112); ac_ += DPP0(ac_, 0x114); ac_ += DPP0(ac_, 0x118); \
                { const float t0_ = __shfl(ac_, 15), t1_ = __shfl(ac_, 31), t2_ = __shfl(ac_, 47); ac_ += (lane >= 16 ? t0_ : 0.f) + (lane >= 32 ? t1_ : 0.f) + (lane >= 48 ? t2_ : 0.f); } \
                const float al_ = __shfl(ac_, 63); const float wl_ = __expf(al_ - ac_) * rdt; eas_[lane] = __expf(ac_); \
                  \
                _Pragma("unroll") for (int i_ = 0; i_ < 4; ++i_) { const int pc_ = lane + 64 * i_; const float w_ = __shfl(wl_, pc_ >> 2); float f_[8]; unpack8(rx[i_], f_); \
                    _Pragma("unroll") for (int e_ = 0; e_ < 8; ++e_) f_[e_] *= w_; \
                    *(LAS u32x4*)(Cs + 128 * 128 + (pc_ >> 2) * XH + 8 * (pc_ & 3)) = pack8(f_); } } } while (0)
#define DPP0(v_, ctrl_) __builtin_bit_cast(float, __builtin_amdgcn_update_dpp(0, __builtin_bit_cast(int, v_), ctrl_, 0xf, 0xf, false))
        if (V & 1) { for (int s = 0; s < 133; ++s) WG_BARRIER(); return; }
        if (pair == 1) { SSD_ISSUE_CB(0); SSD_ISSUE_X(0); SSD_WRITE_CB(); SSD_WRITE_X(); SSD_ISSUE_CB(2); SSD_ISSUE_X(2); } else { SSD_ISSUE_CB(1); SSD_ISSUE_X(1); }
        WG_BARRIER();
        for (int s = 0; s < 132; s += 2) {
            if (pair == 0) { SSD_WRITE_CB(); SSD_WRITE_X(); if (s + 3 < 132) { SSD_ISSUE_CB(s + 3); SSD_ISSUE_X(s + 3); } }
            WG_BARRIER();
            if (pair == 1 && s + 2 < 132) { SSD_WRITE_CB(); SSD_WRITE_X(); if (s + 4 < 132) { SSD_ISSUE_CB(s + 4); SSD_ISSUE_X(s + 4); } }
            WG_BARRIER();
        }
#undef DPP0
#undef SSD_ISSUE_CB
#undef SSD_ISSUE_X
#undef SSD_WRITE_CB
#undef SSD_WRITE_X
#undef BL128
        return;
    }
    const int d = (wave >> 1) & 1, pl = 16 * (wave & 1), pcol = 64 * hh + 32 * ph + pl;
    bf16_t* Y = (V & 8) ? (bf16_t*)(KWS() + WS_TA) : (bf16_t*)(KWS() + WS_Y);
    const auto rY = __builtin_amdgcn_make_buffer_rsrc((void*)Y, (short)0, (int)((size_t)M_LAT * 2048 * 2), 0x00020000);
    if (V & 2) { for (int s = 0; s < 133; ++s) WG_BARRIER(); return; }
    f32x4 hs[8];
#pragma unroll
    for (int i = 0; i < 8; ++i) hs[i] = (f32x4){0.f, 0.f, 0.f, 0.f};
    WG_BARRIER();
    for (int s = 0; s < 132; ++s) {
        const bool latent = s >= 4; const int row0 = SSD_ROW0(s, d);
        u32x4 yl[2] = {};
#define SSD_YVOFF(p_) ((((d ? 63 - (16 * (2 * (p_) + (q & 1)) + n) : (16 * (2 * (p_) + (q & 1)) + n))) * 2048 + pcol + 8 * (q >> 1)) * 2)
        if (latent && !(V & 4) && !(V & 16)) {
#pragma unroll
            for (int p = 0; p < 2; ++p) yl[p] = __builtin_bit_cast(u32x4, __builtin_amdgcn_raw_buffer_load_b128(rY, SSD_YVOFF(p), row0 * 4096, 0));
        }
        const LAS bf16_t* Cp = (const LAS bf16_t*)(lds + (s & 1) * BUFB + d * DIRB); const LAS bf16_t* Bp = Cp + 64 * 128; const LAS bf16_t* Xp = Bp + 64 * 128;
        const LAS float* ea = (const LAS float*)(Xp + 64 * XH);
        bf16x8 hb[4];
#pragma unroll
        for (int ks = 0; ks < 4; ++ks) hb[ks] = acc_frag(hs[2 * ks], hs[2 * ks + 1]);
        bf16x8 btr[8][2]; bf16x8 xb[2];
#pragma unroll
        for (int ks = 0; ks < 2; ++ks)
#pragma unroll
          for (int mt = 0; mt < 8; ++mt) { const LAS bf16_t* p = Bp + (32 * ks + 8 * q + (n >> 2)) * 128 + 8 * (4 * ((mt >> 1) ^ (n >> 2)) + (n & 3)) + 4 * (mt & 1);
              const bf16x4 a = tr4(p), b = tr4(p + 4 * 128); btr[mt][ks] = (bf16x8){a[0], a[1], a[2], a[3], b[0], b[1], b[2], b[3]}; }
#pragma unroll
        for (int ks = 0; ks < 2; ++ks) { const LAS bf16_t* p = Xp + (32 * ks + 8 * q + (n >> 2)) * XH + pl + 4 * (n & 3);
            const bf16x4 x0 = tr4(p), x1 = tr4(p + 4 * XH); xb[ks] = (bf16x8){x0[0], x0[1], x0[2], x0[3], x1[0], x1[1], x1[2], x1[3]}; }
        const float eal = ea[63];
        SBAR
#pragma unroll
        for (int mt = 0; mt < 8; ++mt) hs[mt] = hs[mt] * eal;
#pragma unroll
        for (int ks = 0; ks < 2; ++ks)
#pragma unroll
            for (int mt = 0; mt < 8; ++mt) hs[mt] = mma16(btr[mt][ks], xb[ks], hs[mt]);
        bf16x8 cf[4][4]; f32x4 yT[4]; float eai[4];
#pragma unroll
        for (int ks = 0; ks < 4; ++ks)
#pragma unroll
            for (int ni = 0; ni < 4; ++ni) cf[ni][ks] = *(const LAS bf16x8*)(Cp + (16 * ni + n) * 128 + 8 * ((4 * ks + q) ^ n));
#pragma unroll
        for (int ni = 0; ni < 4; ++ni) eai[ni] = ea[16 * ni + n];
#define ILV(nm_, nd_) __builtin_amdgcn_sched_group_barrier(0x008, nm_, 0); __builtin_amdgcn_sched_group_barrier(0x100, nd_, 0);
        ILV(1, 2) ILV(1, 2) ILV(1, 2) ILV(1, 2) ILV(1, 1) ILV(1, 1) ILV(1, 1) ILV(1, 1) ILV(1, 1) ILV(1, 1) ILV(1, 1) ILV(1, 1) ILV(1, 1) ILV(1, 1) ILV(1, 1) ILV(1, 1)
#undef ILV
        SBAR
#pragma unroll
        for (int ni = 0; ni < 4; ++ni) yT[ni] = (f32x4){0.f, 0.f, 0.f, 0.f};
#pragma unroll
        for (int ks = 0; ks < 4; ++ks)
#pragma unroll
            for (int ni = 0; ni < 4; ++ni) yT[ni] = mma16(hb[ks], cf[ni][ks], yT[ni]);
        SBAR
        if (latent && !(V & 4)) {
            asm volatile("s_waitcnt vmcnt(0)" ::: "memory");
#pragma unroll
            for (int p = 0; p < 2; ++p) { const f32x4 A = yT[2 * p] * eai[2 * p], B = yT[2 * p + 1] * eai[2 * p + 1];
                float o[8]; unpack8(yl[p], o);
#pragma unroll
                for (int e = 0; e < 4; ++e) {
                    const float ae = A[e], be = B[e];
                    const auto r = __builtin_amdgcn_permlane16_swap(__float_as_uint(ae), __float_as_uint(be), false, false);
                    o[e] += __uint_as_float(r[0]); o[4 + e] += __uint_as_float(r[1]); }
                if (!(V & 16)) __builtin_amdgcn_raw_buffer_store_b128(__builtin_bit_cast(decltype(__builtin_amdgcn_raw_buffer_load_b128(rY, 0, 0, 0)), pack8(o)), rY, SSD_YVOFF(p), row0 * 4096, 0); else asm volatile("" :: "v"(o[0]), "v"(o[7])); }
            if (s == 67) asm volatile("s_waitcnt vmcnt(0)" ::: "memory");
        }
        SBAR
        WG_BARRIER();
    }
#undef SSD_YVOFF
#undef SSD_ROW0
}
#undef SBAR

__device__ __forceinline__ void ostat_phase(int first_block) {
    if ((int)blockIdx.x < first_block) return;
    const int lane = threadIdx.x & 63, wave = threadIdx.x >> 6; const int gw = ((int)blockIdx.x - first_block) * 8 + wave, NGW = ((int)gridDim.x - first_block) * 8;
    const bf16_t* of = (const bf16_t*)KOUT(); const bf16_t* ob = of + (size_t)M_LAT * 1024; float* ost = (float*)(KWS() + WS_OST);
    for (int bt = gw; bt < M_LAT / 4; bt += NGW) { const int per = 0, i0 = 4 * bt; (void)per;
        u32x4 x0[4], x1[4], y0[4], y1[4];
#pragma unroll
        for (int r = 0; r < 4; ++r) { const size_t o = (size_t)(i0 + r) * 1024 + 16 * lane; x0[r] = __builtin_nontemporal_load((const u32x4*)(of + o)); x1[r] = __builtin_nontemporal_load((const u32x4*)(of + o + 8)); y0[r] = __builtin_nontemporal_load((const u32x4*)(ob + o)); y1[r] = __builtin_nontemporal_load((const u32x4*)(ob + o + 8)); }
#pragma unroll
        for (int r = 0; r < 4; ++r) { float a0[8], a1[8], b0[8], b1[8]; unpack8(x0[r], a0); unpack8(x1[r], a1); unpack8(y0[r], b0); unpack8(y1[r], b1);
            float s = 0.f;
#pragma unroll
            for (int e = 0; e < 8; ++e) { const float u = a0[e] + b0[e], v = a1[e] + b1[e]; s += u * u + v * v; }
            s += __shfl_xor(s, 1); s += __shfl_xor(s, 2); s += __shfl_xor(s, 4);
            if ((lane & 7) == 0) ost[(size_t)(i0 + r) * 8 + (lane >> 3)] = rsqrtf(s * (1.f / 128.f) + EPS); }
    }
}
__device__ __forceinline__ void ynorm_phase(const Args& a) {
    const int lane = threadIdx.x & 63, wave = threadIdx.x >> 6; const int gw = blockIdx.x * 8 + wave, NGW = gridDim.x * 8;
    const float* ps = (const float*)(KWS() + WS_PS); float* rat = (float*)(KWS() + WS_RAT);
    for (int row = gw; row < M_LAT; row += NGW) {
        float s = ps[(size_t)row * 64 + lane];
        s += __shfl_xor(s, 1); s += __shfl_xor(s, 2); s += __shfl_xor(s, 4); s += __shfl_xor(s, 8);
        const float r = rsqrtf(s * (1.f / 512.f) + EPS), rn = __shfl(r, (lane + 16) & 63);
        if ((lane & 15) == 0) rat[(size_t)row * 4 + (lane >> 4)] = (lane < 48) ? r / rn : r;
    }
}
__device__ __forceinline__ void fnorm_phase(const Args& a) {
    const int lane = threadIdx.x & 63, wave = threadIdx.x >> 6; const int gw = blockIdx.x * 8 + wave, NGW = gridDim.x * 8;
    const bf16_t* P = (const bf16_t*)(KWS() + WS_P); bf16_t* h1 = (bf16_t*)(KWS() + WS_H1); const float* mod = (const float*)(KWS() + WS_MOD); bf16_t* F = (bf16_t*)(KWS() + WS_F); const float* X = KIN(I_X);
    const int per = M_LAT / NGW;
    const int b = (gw * per) / SEQ;
    f32x4 sc[4], sh[4];
#pragma unroll
    for (int j = 0; j < 4; ++j) { const int c = 4 * lane + 256 * j; const f32x4 w = *(const f32x4*)(KIN(I_N2W) + c), s2 = *(const f32x4*)(mod + b * 6144 + 4096 + c);
        sc[j] = w * (s2 + 1.0f); sh[j] = *(const f32x4*)(mod + b * 6144 + 3072 + c); }
    for (int i0 = 0; i0 < per; i0 += 4) {
        f32x4 v[4][4]; u32x2 pw[4][4];
#pragma unroll
        for (int r = 0; r < 4; ++r) { const size_t row = gw * per + i0 + r;
#pragma unroll
            for (int j = 0; j < 4; ++j) { v[r][j] = __builtin_nontemporal_load((const f32x4*)(X + row * 1024 + 4 * lane + 256 * j)); pw[r][j] = __builtin_nontemporal_load((const u32x2*)(P + row * 1024 + 4 * lane + 256 * j)); } }
#pragma unroll
        for (int r = 0; r < 4; ++r) { const size_t row = gw * per + i0 + r; float ss = 0.f;
#pragma unroll
            for (int j = 0; j < 4; ++j) { v[r][j] = v[r][j] + (f32x4){bflo(pw[r][j].x), bfhi(pw[r][j].x), bflo(pw[r][j].y), bfhi(pw[r][j].y)};
                ss += (v[r][j][0] * v[r][j][0] + v[r][j][1] * v[r][j][1]) + (v[r][j][2] * v[r][j][2] + v[r][j][3] * v[r][j][3]); }
            const float rs = rsqrtf(wave_sum(ss) * (1.f / 1024.f) + EPS);
#pragma unroll
            for (int j = 0; j < 4; ++j) { const f32x4 o = v[r][j] * rs * sc[j] + sh[j];
                u32x2 w; w.x = cvt_pk_bf16(o[0], o[1]); w.y = cvt_pk_bf16(o[2], o[3]); *(u32x2*)(F + row * 1024 + 4 * lane + 256 * j) = w;
                u32x2 hw; hw.x = cvt_pk_bf16(v[r][j][0], v[r][j][1]); hw.y = cvt_pk_bf16(v[r][j][2], v[r][j][3]); __builtin_nontemporal_store(hw, (u32x2*)(h1 + row * 1024 + 4 * lane + 256 * j)); } }
    }
}
__device__ __forceinline__ void final_phase(const Args& a) {
    const int lane = threadIdx.x & 63, wave = threadIdx.x >> 6; const int gw = blockIdx.x * 8 + wave, NGW = gridDim.x * 8, per = M_LAT / NGW;
    float* out = KOUT(); const bf16_t* h1 = (const bf16_t*)(KWS() + WS_H1); const bf16_t* P = (const bf16_t*)(KWS() + WS_P);
    f32x4 wv[4];
#pragma unroll
    for (int j = 0; j < 4; ++j) wv[j] = *(const f32x4*)(KIN(I_NFW) + 4 * lane + 256 * j);
    for (int i0 = 0; i0 < per; i0 += 4) {
        u32x2 hw[4][4], pw[4][4];
#pragma unroll
        for (int r = 0; r < 4; ++r) { const size_t row = gw * per + i0 + r;
#pragma unroll
            for (int j = 0; j < 4; ++j) { hw[r][j] = __builtin_nontemporal_load((const u32x2*)(h1 + row * 1024 + 4 * lane + 256 * j)); pw[r][j] = __builtin_nontemporal_load((const u32x2*)(P + row * 1024 + 4 * lane + 256 * j)); } }
#pragma unroll
        for (int r = 0; r < 4; ++r) { const size_t row = gw * per + i0 + r; float ss = 0.f; f32x4 v[4];
#pragma unroll
            for (int j = 0; j < 4; ++j) { v[j] = (f32x4){bflo(hw[r][j].x), bfhi(hw[r][j].x), bflo(hw[r][j].y), bfhi(hw[r][j].y)} + (f32x4){bflo(pw[r][j].x), bfhi(pw[r][j].x), bflo(pw[r][j].y), bfhi(pw[r][j].y)};
                ss += (v[j][0] * v[j][0] + v[j][1] * v[j][1]) + (v[j][2] * v[j][2] + v[j][3] * v[j][3]); }
            const float rs = rsqrtf(wave_sum(ss) * (1.f / 1024.f) + EPS);
#pragma unroll
            for (int j = 0; j < 4; ++j) __builtin_nontemporal_store(v[j] * rs * wv[j], (f32x4*)(out + row * 1024 + 4 * lane + 256 * j)); }
    }
}

__global__ void __launch_bounds__(512, 2) fwd_kernel(Args a) {
    extern __shared__ __attribute__((aligned(16))) unsigned char lds_raw[];
    LAS unsigned char* lds = (LAS unsigned char*)lds_raw;
    cg::grid_group grid = cg::this_grid();
    const int lo = a.ph_lo, hi = a.ph_hi, G = gridDim.x, bx = blockIdx.x;
    unsigned char* ws = KWS(); (void)ws;
    volatile LAS unsigned* bst = (volatile LAS unsigned*)(lds + LDS_BYTES - 64);
    if (threadIdx.x < 2) bst[threadIdx.x] = 0u;
    __syncthreads();
    XcdBarrier xbar = xcd_barrier_post((unsigned*)(ws + WS_CTL), bst);
    if (lo > 1000) grid.sync();
#define IN(k) (lo <= (k) && (k) < hi)
#define SEAM(k) do { if (IN(k) && IN((k) + 1)) { xcd_barrier(xbar); } } while (0)
    using namespace pg8;
    if (IN(0)) p0_prologue(a, lds);
    SEAM(0);
    if (IN(1)) p1_norm_mod(a);
    SEAM(1);
    if (IN(2)) {
        Gemm g{(const bf16_t*)(ws + WS_A), (const bf16_t*)(ws + WS_W1A), M_ALL, N1A, 1024}; StaticOrder S; S.init(M_ALL, N1A, G, bx);
        EpiConv E{(bf16_t*)(ws + WS_QKV), QKV_LD, KIN(I_GCW), KIN(I_GCB), 12, (float*)(ws + WS_SMALL), (const float*)(ws + WS_PAR), (LAS float*)(lds + XL_OFF)};
        gemm_phase<EpiConv, StaticOrder, true, true>(lds, g, S, E);
        if ((int)bx >= 180) { __syncthreads(); weight_convert(lds, N_ITEMS_W1A, N_ITEMS_W1B_END, ((int)bx - 180) * 8 + (threadIdx.x >> 6), (G - 180) * 8); } }
    SEAM(2);
    if (IN(3)) gdn_prep_phase<0>(lds);
    SEAM(3);
    if (IN(4)) gdn_scan_phase<0>(lds);
    SEAM(4);
    if (IN(5)) {
        Gemm g{(const bf16_t*)(ws + WS_A), (const bf16_t*)(ws + WS_W1B), M_LAT, N1B, 1024}; StaticOrder S; S.init(M_LAT, N1B, G, bx);
        EpiConv E{(bf16_t*)(ws + WS_XBC), XBC_LD, KIN(I_SCW), KIN(I_SCB), 12, nullptr, nullptr, (LAS float*)(lds + XL_OFF)};
        gemm_phase<EpiConv, StaticOrder, true, true>(lds, g, S, E);
        { const u32x4* src = (const u32x4*)(ws + WS_XCT); u32x4* dst = (u32x4*)((bf16_t*)(ws + WS_XBC) + (size_t)M_LAT * XBC_LD);
          for (int i = (int)bx * 512 + (int)threadIdx.x; i < CTXL * NB * XBC_LD * 2 / 16; i += G * 512) dst[i] = src[i]; }
        ostat_phase(0); }
    SEAM(5);
    if (IN(6)) ssd_diag_phase(lds);
    SEAM(6);
    if (IN(7)) ssd_scan_phase<0>(lds);
    SEAM(7);
    if (IN(8)) ;
    if (IN(9)) {
        Gemm g{(const bf16_t*)(ws + WS_A), (const bf16_t*)(ws + WS_WZ), M_LAT, NZ, 1024}; StaticOrder S; S.init(M_LAT, NZ, G, bx);
        EpiZ E{(bf16_t*)KOUT(), (const bf16_t*)KOUT() + (size_t)M_LAT * 1024, (const float*)(ws + WS_OST), KIN(I_GNW), (bf16_t*)(ws + WS_Y), (float*)(ws + WS_PS), (bf16_t*)(ws + WS_GATES)};
        gemm_phase<EpiZ, StaticOrder, true, true>(lds, g, S, E); }
    SEAM(9);
    if (IN(10)) ynorm_phase(a);
    if (IN(11)) {
        Gemm g{(const bf16_t*)KOUT(), (const bf16_t*)(ws + WS_WBG), M_LAT, 1024, 1024}; StaticOrder S; S.init(M_LAT, 1024, G, bx);
        EpiBR<0> E{(const bf16_t*)(ws + WS_GATES), (bf16_t*)(ws + WS_M1), nullptr, nullptr};
        gemm_phase<EpiBR<0>, StaticOrder, true, true>(lds, g, S, E); }
    SEAM(11);
    if (IN(12)) {
        Gemm g{(const bf16_t*)(ws + WS_Y), (const bf16_t*)(ws + WS_WBS), M_LAT, 1024, 2048}; StaticOrder S; S.init(M_LAT, 1024, G, bx);
        EpiBR<1> E{(const bf16_t*)(ws + WS_GATES), (bf16_t*)(ws + WS_M1), (bf16_t*)(ws + WS_A), (const float*)(ws + WS_RAT)};
        gemm_phase<EpiBR<1>, StaticOrder, true, true>(lds, g, S, E); }
    SEAM(12);
    if (IN(13)) {
        Gemm g{(const bf16_t*)(ws + WS_A), (const bf16_t*)(ws + WS_WO), M_LAT, 1024, 1024}; StaticOrder S; S.init(M_LAT, 1024, G, bx);
        EpiP E{(bf16_t*)(ws + WS_P), (const float*)(ws + WS_MOD) + 2048};
        gemm_phase<EpiP, StaticOrder, true, true>(lds, g, S, E); }
    SEAM(13);
    if (IN(14)) fnorm_phase(a);
    SEAM(14);
    if (IN(15)) {
        Gemm g{(const bf16_t*)(ws + WS_F), (const bf16_t*)(ws + WS_WF1), M_LAT, NF1, 1024}; StaticOrder S; S.init(M_LAT, NF1, G, bx);
        EpiFF1 E{(bf16_t*)(ws + WS_ACT)};
        gemm_phase<EpiFF1, StaticOrder, true, true>(lds, g, S, E); }
    SEAM(15);
    if (IN(16)) {
        Gemm g{(const bf16_t*)(ws + WS_ACT), (const bf16_t*)(ws + WS_WF2), M_LAT, 1024, DFF}; StaticOrder S; S.init(M_LAT, 1024, G, bx);
        EpiP E{(bf16_t*)(ws + WS_P), (const float*)(ws + WS_MOD) + 5120};
        gemm_phase<EpiP, StaticOrder, true, true>(lds, g, S, E); }
    SEAM(16);
    if (IN(17)) final_phase(a);
#undef IN
#undef SEAM
}

extern "C" void kernel_launch(void* const* d_in, const int* in_sizes, int n_in, void* d_out, int out_size, void* d_ws, size_t ws_size, hipStream_t stream) {
    static int grid = 0;
    if (grid == 0) {
        int dev = 0, cus = 0, per_cu = 0;
        if (hipGetDevice(&dev) != hipSuccess || hipDeviceGetAttribute(&cus, hipDeviceAttributeMultiprocessorCount, dev) != hipSuccess) { fprintf(stderr, "kernel_launch: device query failed\n"); grid = -1; return; }
        if (hipFuncSetAttribute((const void*)fwd_kernel, hipFuncAttributeMaxDynamicSharedMemorySize, LDS_BYTES) != hipSuccess) { fprintf(stderr, "kernel_launch: hipFuncSetAttribute(%d) failed\n", LDS_BYTES); grid = -1; return; }
        if (hipOccupancyMaxActiveBlocksPerMultiprocessor(&per_cu, (const void*)fwd_kernel, 512, LDS_BYTES) != hipSuccess || per_cu < 1) { fprintf(stderr, "kernel_launch: occupancy query says %d\n", per_cu); per_cu = 1; }
        (void)hipGetLastError();
        grid = 256;
        if (cus < 256) { fprintf(stderr, "kernel_launch: this kernel needs 256 CUs (found %d)\n", cus); grid = -1; return; }
        fprintf(stderr, "kernel_launch: cus %d per_cu %d ws %zu n_in %d\n", cus, per_cu, ws_size, n_in);
        if (ws_size < WS_END || n_in != 26) { fprintf(stderr, "kernel_launch: unexpected ws_size/n_in\n"); }
    }
    if (grid < 0) return;
    if (hipMemsetAsync((char*)d_ws + WS_CTL, 0, 64 * 1024, stream) != hipSuccess) { fprintf(stderr, "kernel_launch: memset failed\n"); return; }
    Args a{};
    for (int i = 0; i < 26; ++i) a.in[i] = (const float*)d_in[i];
    a.out = (float*)d_out; a.ws = (unsigned char*)d_ws;
#if MK_PER_PHASE
    for (int ph = 0; ph <= 17; ++ph) { a.ph_lo = ph; a.ph_hi = ph + 1; hipLaunchKernelGGL(fwd_kernel, dim3(grid), dim3(512), LDS_BYTES, stream, a); }
#else
    a.ph_lo = 0; a.ph_hi = 18;
    void* args[] = {&a};
    hipError_t e = hipLaunchCooperativeKernel((void*)fwd_kernel, dim3(grid), dim3(512), args, LDS_BYTES, stream);
    if (e != hipSuccess) fprintf(stderr, "cooperative launch failed: %s (grid %d)\n", hipGetErrorString(e), grid);
#endif
}
```
